# Optimizing an MI355X kernel written in HIP

```python
import functools
import jax, jax.numpy as jnp
from jax import lax
import numpy as np

D_MODEL = 1024
BATCH = 2
SEQ = 8192
DEPTH = 2

GRID_W = 64
CTX_LEN = 256
N_BRANCH = 4
BRANCH_W = 512
EPS = 1e-6

NA_HEADS = 8
NA_HEAD_DIM = BRANCH_W // NA_HEADS
NA_ROWS = 8
NA_COLS = 16

POOL_WINDOWS = (2, 4, 8, 16)
POOL_GROUP = BRANCH_W // len(POOL_WINDOWS)

MLA_HEADS = 8
MLA_Q_LORA = 384
MLA_KV_LORA = 256
MLA_NOPE = 64
MLA_ROPE = 32
MLA_V = BRANCH_W // MLA_HEADS
MLA_BLOCK = 128
ROPE_BASE = 10000.0

CONV_W = BRANCH_W
CONV_K = 3

D_FF = 2816
N_EXPERTS = 8
TOP_K = 2
D_FF_EXPERT = 3584
N_DENSE = (DEPTH + 1) // 2
N_MOE = DEPTH // 2

IN_SIZES = (BRANCH_W, BRANCH_W, BRANCH_W,
            BRANCH_W,
            MLA_Q_LORA, MLA_KV_LORA, MLA_ROPE,
            CONV_W, CONV_W, CONV_W,
            N_BRANCH * D_MODEL)
IN_COLS = sum(IN_SIZES)
IN_SPLITS = tuple(int(s) for s in np.cumsum(IN_SIZES)[:-1])

kernel_name = 'hybrid_parallel_branch_dit_block'


def rms_norm(x, g):
    xf = x.astype(jnp.float32)
    xf = xf * lax.rsqrt(jnp.mean(jnp.square(xf), axis=-1, keepdims=True) + EPS)
    return (xf * g.astype(jnp.float32)).astype(x.dtype)


def modulate(h, shift, scale):
    return h * (1 + scale) + shift


def softmax_f32(s, dtype):
    return jax.nn.softmax(s.astype(jnp.float32), axis=-1).astype(dtype)


def axial_rope_tables(n_tokens):
    pos = jnp.arange(n_tokens)
    row = (pos // GRID_W).astype(jnp.float32)
    col = (pos % GRID_W).astype(jnp.float32)
    n_pairs = MLA_ROPE // 4
    inv_freq = ROPE_BASE ** (-jnp.arange(n_pairs, dtype=jnp.float32) / n_pairs)
    ang = jnp.concatenate([row[:, None] * inv_freq, col[:, None] * inv_freq], axis=-1)
    return jnp.cos(ang), jnp.sin(ang)


def apply_rope(t, cos, sin):
    tp = t.astype(jnp.float32).reshape(t.shape[:-1] + (t.shape[-1] // 2, 2))
    a, b = tp[..., 0], tp[..., 1]
    out = jnp.stack([a * cos - b * sin, a * sin + b * cos], axis=-1)
    return out.reshape(t.shape).astype(t.dtype)


def na_heads(t):
    return t.reshape(t.shape[0], t.shape[1], NA_HEADS, NA_HEAD_DIM)


def neighbourhood_attention(q, k, v, k_ctx, v_ctx, rpb):
    B, S, H, Dh = q.shape
    rows = S // GRID_W
    kr = min(NA_ROWS, rows)
    n_loc = kr * NA_COLS
    scale = Dh ** -0.5
    r = jnp.arange(rows)
    col = jnp.arange(GRID_W)
    key_rows = jnp.clip(r - kr // 2, 0, rows - kr)[:, None] + jnp.arange(kr)
    key_cols = jnp.clip(col - NA_COLS // 2, 0, GRID_W - NA_COLS)[:, None] + jnp.arange(NA_COLS)
    d_row = key_rows - r[:, None] + (NA_ROWS - 1)
    d_col = key_cols - col[:, None] + (NA_COLS - 1)
    bias_col = rpb[:, :, d_col]
    q_rows = q.reshape(B, rows, GRID_W, H, Dh).transpose(1, 0, 2, 3, 4)

    def row_block(args):
        q_r, rows_r, drow_r = args
        idx = (rows_r[None, :, None] * GRID_W + key_cols[:, None, :]).reshape(GRID_W, n_loc)
        k_g = k[:, idx]
        v_g = v[:, idx]
        bias = bias_col[:, drow_r].transpose(0, 2, 1, 3).reshape(H, GRID_W, n_loc)
        s_loc = jnp.einsum('bqhd,bqnhd->bhqn', q_r, k_g) * scale + bias
        s_ctx = jnp.einsum('bqhd,bchd->bhqc', q_r, k_ctx) * scale
        p = softmax_f32(jnp.concatenate([s_loc, s_ctx], axis=-1), v.dtype)
        return (jnp.einsum('bhqn,bqnhd->bqhd', p[..., :n_loc], v_g)
                + jnp.einsum('bhqc,bchd->bqhd', p[..., n_loc:], v_ctx))

    out = lax.map(row_block, (q_rows, key_rows, d_row))
    return out.transpose(1, 0, 2, 3, 4).reshape(B, S, H * Dh)


def context_attention(q, k, v):
    s = jnp.einsum('bqhd,bkhd->bhqk', q, k) * (q.shape[-1] ** -0.5)
    p = softmax_f32(s, v.dtype)
    return jnp.einsum('bhqk,bkhd->bqhd', p, v).reshape(q.shape[0], q.shape[1], -1)


def multiscale_pool(u):
    B, N, _ = u.shape
    uf = u.astype(jnp.float32)
    csum = jnp.pad(jnp.cumsum(uf, axis=1), ((0, 0), (1, 0), (0, 0)))
    t = jnp.arange(N)
    outs = []
    for g, w in enumerate(POOL_WINDOWS):
        lo = jnp.clip(t - w // 2, 0, N)
        hi = jnp.clip(t - w // 2 + w, 0, N)
        sl = slice(g * POOL_GROUP, (g + 1) * POOL_GROUP)
        cnt = (hi - lo).astype(jnp.float32)[None, :, None]
        outs.append((csum[:, hi, sl] - csum[:, lo, sl]) / cnt - uf[:, :, sl])
    return jnp.concatenate(outs, axis=-1).astype(u.dtype)


def pool_branch(u, pool_w, pool_scale):
    B, N, _ = u.shape
    pooled = multiscale_pool(u).reshape(B, N, len(POOL_WINDOWS), POOL_GROUP)
    mixed = jnp.einsum('bngc,gcd->bngd', pooled, pool_w).reshape(B, N, BRANCH_W)
    return mixed * pool_scale


def mla_queries(c_q, g_q, w_uq):
    B, N, _ = c_q.shape
    q = (rms_norm(c_q, g_q) @ w_uq).reshape(B, N, MLA_HEADS, MLA_NOPE + MLA_ROPE)
    return q[..., :MLA_NOPE], q[..., MLA_NOPE:]


def mla_keys_values(c_kv, g_kv, w_ukv):
    B, N, _ = c_kv.shape
    kv = (rms_norm(c_kv, g_kv) @ w_ukv).reshape(B, N, MLA_HEADS, MLA_NOPE + MLA_V)
    return kv[..., :MLA_NOPE], kv[..., MLA_NOPE:]


def mla_scores(qn, qr, kn, kr):
    s = jnp.einsum('bqhd,bkhd->bhqk', qn, kn) + jnp.einsum('bqhr,bkr->bhqk', qr, kr)
    return s * ((MLA_NOPE + MLA_ROPE) ** -0.5)


def mla_latent_attention(qn, qr, kn, kr, v, kn_c, kr_c, v_c):
    B, S, H, _ = qn.shape
    nb = S // MLA_BLOCK

    def block(args):
        qn_b, qr_b = args
        s = jnp.concatenate([mla_scores(qn_b, qr_b, kn, kr), mla_scores(qn_b, qr_b, kn_c, kr_c)], axis=-1)
        p = softmax_f32(s, v.dtype)
        return (jnp.einsum('bhqk,bkhd->bqhd', p[..., :S], v)
                + jnp.einsum('bhqk,bkhd->bqhd', p[..., S:], v_c))

    to_blocks = lambda t: t.reshape((B, nb, MLA_BLOCK) + t.shape[2:]).swapaxes(0, 1)
    out = lax.map(block, (to_blocks(qn), to_blocks(qr)))
    return out.swapaxes(0, 1).reshape(B, S, H * MLA_V)


def mla_context_attention(qn, qr, kn, kr, v):
    p = softmax_f32(mla_scores(qn, qr, kn, kr), v.dtype)
    return jnp.einsum('bhqk,bkhd->bqhd', p, v).reshape(qn.shape[0], qn.shape[1], -1)


def short_conv(u, w):
    return lax.conv_general_dilated(
        u, w[:, None, :].astype(u.dtype), window_strides=(1,),
        padding=((CONV_K // 2, CONV_K // 2),),
        dimension_numbers=('NWC', 'WIO', 'NWC'), feature_group_count=u.shape[-1])


def merge_branches(outs, gate_pre, w_branch):
    o = jnp.stack(outs, axis=-2)
    proj = jnp.einsum('bnko,kod->bnkd', o, w_branch)
    g = jax.nn.sigmoid(gate_pre.reshape(gate_pre.shape[:-1] + (N_BRANCH, D_MODEL)))
    return jnp.sum(g * proj, axis=-2)


def token_mixer(h, hc, cos, sin, w_in, rpb, pool_w, pool_scale, g_q, w_uq, g_kv, w_ukv,
                conv_w, w_branch, w_out, with_ctx_out):
    (q_a, k_a, v_a, u_p, c_q, c_kv, k_r, b_g, c_g, x_c, gate) = jnp.split(h @ w_in, IN_SPLITS, axis=-1)
    (q_ac, k_ac, v_ac, u_pc, c_qc, c_kvc, k_rc, b_gc, c_gc, x_cc, gate_c) = jnp.split(hc @ w_in, IN_SPLITS, axis=-1)
    k_na_c, v_na_c = na_heads(k_ac), na_heads(v_ac)
    kn_c, vm_c = mla_keys_values(c_kvc, g_kv, w_ukv)

    o_a = neighbourhood_attention(na_heads(q_a), na_heads(k_a), na_heads(v_a), k_na_c, v_na_c, rpb)
    o_b = pool_branch(u_p, pool_w, pool_scale)
    qn, qr = mla_queries(c_q, g_q, w_uq)
    kn, vm = mla_keys_values(c_kv, g_kv, w_ukv)
    o_c = mla_latent_attention(qn, apply_rope(qr, cos[:, None], sin[:, None]), kn,
                               apply_rope(k_r, cos, sin), vm, kn_c, k_rc, vm_c)
    o_d = b_g * short_conv(c_g * x_c, conv_w)
    y = merge_branches((o_a, o_b, o_c, o_d), gate, w_branch) @ w_out
    if not with_ctx_out:
        return y, None

    o_ac = context_attention(na_heads(q_ac), k_na_c, v_na_c)
    o_bc = pool_branch(u_pc, pool_w, pool_scale)
    qn_c, qr_c = mla_queries(c_qc, g_q, w_uq)
    o_cc = mla_context_attention(qn_c, qr_c, kn_c, k_rc, vm_c)
    o_dc = b_gc * short_conv(c_gc * x_cc, conv_w)
    yc = merge_branches((o_ac, o_bc, o_cc, o_dc), gate_c, w_branch) @ w_out
    return y, yc


def swiglu(t, w1, w3, w2):
    return (jax.nn.silu(t @ w1) * (t @ w3)) @ w2


def moe_swiglu(t, router, w1, w3, w2):
    logits = (t @ router).astype(jnp.float32)
    top_v, top_i = lax.top_k(logits, TOP_K)
    wts = jax.nn.softmax(top_v, axis=-1)
    combine = jnp.sum(jax.nn.one_hot(top_i, N_EXPERTS, dtype=jnp.float32) * wts[..., None], axis=-2).astype(t.dtype)
    y = jnp.zeros_like(t)
    for e in range(N_EXPERTS):
        y = y + combine[..., e:e + 1] * swiglu(t, w1[e], w3[e], w2[e])
    return y


def setup_inputs(seed: int = 0) -> dict:
    key = jax.random.key(seed)
    ks = jax.random.split(key, 32)
    nrm = lambda k, shape, fan_in: jax.random.normal(k, shape, jnp.float32) * (fan_in ** -0.5)
    gain = lambda k, shape: 1.0 + 0.05 * jax.random.normal(k, shape, jnp.float32)
    return {
        'x': jax.random.normal(ks[0], (BATCH, SEQ, D_MODEL), jnp.float32),
        'c': jax.random.normal(ks[1], (BATCH, D_MODEL), jnp.float32),
        'ctx': jax.random.normal(ks[2], (BATCH, CTX_LEN, D_MODEL), jnp.float32),
        'c_ctx': jax.random.normal(ks[3], (D_MODEL,), jnp.float32),
        'w_ada': 0.5 * nrm(ks[4], (DEPTH, D_MODEL, 6 * D_MODEL), D_MODEL),
        'b_ada': 0.02 * jax.random.normal(ks[5], (DEPTH, 6 * D_MODEL), jnp.float32),
        'g_norm': gain(ks[6], (DEPTH, 4, D_MODEL)),
        'w_in': nrm(ks[7], (DEPTH, D_MODEL, IN_COLS), D_MODEL),
        'na_rpb': 0.1 * jax.random.normal(ks[8], (DEPTH, NA_HEADS, 2 * NA_ROWS - 1, 2 * NA_COLS - 1), jnp.float32),
        'pool_w': nrm(ks[9], (DEPTH, len(POOL_WINDOWS), POOL_GROUP, POOL_GROUP), POOL_GROUP),
        'pool_scale': gain(ks[10], (DEPTH, BRANCH_W)),
        'mla_g_q': gain(ks[11], (DEPTH, MLA_Q_LORA)),
        'mla_w_uq': nrm(ks[12], (DEPTH, MLA_Q_LORA, MLA_HEADS * (MLA_NOPE + MLA_ROPE)), MLA_Q_LORA),
        'mla_g_kv': gain(ks[13], (DEPTH, MLA_KV_LORA)),
        'mla_w_ukv': nrm(ks[14], (DEPTH, MLA_KV_LORA, MLA_HEADS * (MLA_NOPE + MLA_V)), MLA_KV_LORA),
        'conv_w': nrm(ks[15], (DEPTH, CONV_K, CONV_W), CONV_K),
        'w_branch': nrm(ks[16], (DEPTH, N_BRANCH, BRANCH_W, D_MODEL), BRANCH_W),
        'w_out': nrm(ks[17], (DEPTH, D_MODEL, D_MODEL), D_MODEL),
        'ffn_w1': nrm(ks[18], (N_DENSE, D_MODEL, D_FF), D_MODEL),
        'ffn_w3': nrm(ks[19], (N_DENSE, D_MODEL, D_FF), D_MODEL),
        'ffn_w2': nrm(ks[20], (N_DENSE, D_FF, D_MODEL), D_FF),
        'moe_router': nrm(ks[21], (N_MOE, D_MODEL, N_EXPERTS), D_MODEL),
        'moe_w1': nrm(ks[22], (N_MOE, N_EXPERTS, D_MODEL, D_FF_EXPERT), D_MODEL),
        'moe_w3': nrm(ks[23], (N_MOE, N_EXPERTS, D_MODEL, D_FF_EXPERT), D_MODEL),
        'moe_w2': nrm(ks[24], (N_MOE, N_EXPERTS, D_FF_EXPERT, D_MODEL), D_FF_EXPERT),
    }


def reference(x, c, ctx, c_ctx, w_ada, b_ada, g_norm, w_in, na_rpb, pool_w, pool_scale,
              mla_g_q, mla_w_uq, mla_g_kv, mla_w_ukv, conv_w, w_branch, w_out,
              ffn_w1, ffn_w3, ffn_w2, moe_router, moe_w1, moe_w3, moe_w2):
    B, S, _ = x.shape
    cos, sin = axial_rope_tables(S)
    cx = ctx
    for l in range(DEPTH):
        ctx_needed = l < DEPTH - 1
        mod = (jax.nn.silu(c) @ w_ada[l] + b_ada[l]).reshape(B, 6, 1, D_MODEL)
        mod_c = (jax.nn.silu(c_ctx) @ w_ada[l] + b_ada[l]).reshape(6, D_MODEL)

        h = modulate(rms_norm(x, g_norm[l, 0]), mod[:, 0], mod[:, 1])
        hc = modulate(rms_norm(cx, g_norm[l, 0]), mod_c[0], mod_c[1])
        y, yc = token_mixer(h, hc, cos, sin, w_in[l], na_rpb[l], pool_w[l], pool_scale[l],
                            mla_g_q[l], mla_w_uq[l], mla_g_kv[l], mla_w_ukv[l], conv_w[l],
                            w_branch[l], w_out[l], ctx_needed)
        x = x + mod[:, 2] * rms_norm(y, g_norm[l, 1])

        if l % 2 == 0:
            ffn = functools.partial(swiglu, w1=ffn_w1[l // 2], w3=ffn_w3[l // 2], w2=ffn_w2[l // 2])
        else:
            ffn = functools.partial(moe_swiglu, router=moe_router[l // 2], w1=moe_w1[l // 2],
                                    w3=moe_w3[l // 2], w2=moe_w2[l // 2])
        x = x + mod[:, 5] * rms_norm(ffn(modulate(rms_norm(x, g_norm[l, 2]), mod[:, 3], mod[:, 4])), g_norm[l, 3])

        if ctx_needed:
            cx = cx + mod_c[2] * rms_norm(yc, g_norm[l, 1])
            cx = cx + mod_c[5] * rms_norm(ffn(modulate(rms_norm(cx, g_norm[l, 2]), mod_c[3], mod_c[4])), g_norm[l, 3])
    return x
```

```cpp
#include <hip/hip_runtime.h>
#include <cstdio>
#include <cstdint>

#define GAS __attribute__((address_space(1)))
#define LAS __attribute__((address_space(3)))
typedef unsigned short bf16;
typedef short bf16x8 __attribute__((ext_vector_type(8)));
typedef float f32x4 __attribute__((ext_vector_type(4)));
typedef float f32x16 __attribute__((ext_vector_type(16)));
typedef unsigned u32x4 __attribute__((ext_vector_type(4)));
typedef unsigned u32x2 __attribute__((ext_vector_type(2)));
typedef GAS unsigned gu32;
typedef int i32x4 __attribute__((ext_vector_type(4)));
typedef int i32x8 __attribute__((ext_vector_type(8)));

constexpr int TL = 16384, TC = 512, T = TL + TC, DM = 1024, SEQ = 8192, CTXL = 256;
constexpr int NPROJ = 8448;
constexpr int C_QA = 0, C_KA = 512, C_VA = 1024, C_UP = 1536, C_BG = 2048, C_CG = 2560, C_XC = 3072, C_GATE = 3584, C_CQ = 7680, C_CKV = 8064, C_KR = 8320;
constexpr int NREF = 8352;
constexpr int DFF = 2816, DFE = 3584, NEXP = 8;
constexpr int MAXPAN = 136;
constexpr float EPS = 1e-6f;
constexpr float LOG2E = 1.4426950408889634f;
constexpr float QS_NA = 0.125f * LOG2E;
constexpr float QS_MLA = 0.10206207261596577f * LOG2E;

constexpr size_t MiB = 1u << 20;
constexpr size_t WS_CTL = 0, CTL_ZERO_BYTES = 1 * MiB;
constexpr size_t WS_MOD = 1 * MiB;
constexpr size_t WS_ROPE = WS_MOD + 256 * 1024;
constexpr size_t WS_RS = WS_MOD + 512 * 1024;
constexpr size_t WS_ROUTE = 2 * MiB;
constexpr size_t WS_SLOTW = 2 * MiB + 512 * 1024;
constexpr size_t WS_TOK2SLOT = 2 * MiB + 768 * 1024;
constexpr size_t WS_BLKCNT = 2 * MiB + 960 * 1024;
constexpr size_t WS_KR = 3 * MiB;
constexpr size_t WS_XC = 5 * MiB;
constexpr size_t WS_WOTHER = 8 * MiB;
constexpr size_t WS_PROJ = 74 * MiB;
constexpr size_t WS_O = 347 * MiB;
constexpr size_t WS_H8 = WS_O;
constexpr size_t WS_C = 414 * MiB;
constexpr size_t WS_D = 447 * MiB;
constexpr size_t WS_E = 480 * MiB;
constexpr size_t WS_END = 548 * MiB;
constexpr size_t WS_WMOE13 = 8 * MiB;
constexpr size_t WS_WMOE2 = 120 * MiB;
constexpr size_t WS_HIDM = 176 * MiB;
constexpr size_t WL_WIN = 0, WL_WUQ = WL_WIN + (size_t)NPROJ * 1024 * 2, WL_WUKV = WL_WUQ + 768 * 384 * 2, WL_WPOOL = WL_WUKV + 1024 * 256 * 2,
                 WL_WBR = WL_WPOOL + 512 * 512 * 2, WL_WOUT = WL_WBR + (size_t)4 * 1024 * 512 * 2, WL_SIZE = WL_WOUT + 1024 * 1024 * 2;
constexpr size_t WO_F13 = 2 * WL_SIZE, WO_F2 = WO_F13 + (size_t)2 * DFF * 1024 * 2, WO_END = WO_F2 + (size_t)1024 * DFF * 2;
static_assert(WO_END <= 66 * MiB, "W_other fits");
static_assert(WS_PROJ + (size_t)T * NPROJ * 2 <= WS_O && WS_O + (size_t)T * 2048 * 2 <= WS_C && WS_C + (size_t)T * 1024 * 2 <= WS_D && WS_D + (size_t)T * 1024 * 2 <= WS_E, "map");
static_assert(WS_HIDM + (size_t)MAXPAN * 256 * DFE * 2 <= WS_C && WS_E + (size_t)MAXPAN * 256 * 1024 * 2 <= WS_END, "map2");
static_assert(WS_WMOE13 + (size_t)8 * 7168 * 1024 * 2 <= WS_WMOE2 && WS_WMOE2 + (size_t)8 * 1024 * DFE * 2 <= WS_HIDM, "map3");
constexpr int CW_TMO = 0, CW_BAR = 4096, CW_CNT = 16384;

constexpr int RING_BYTES = 131072, LDSCTL_OFF = RING_BYTES, MISC_OFF = LDSCTL_OFF + 320, LDS_BYTES = 147456;

#define RLX_AGENT __ATOMIC_RELAXED, __HIP_MEMORY_SCOPE_AGENT
#define LDS_WAIT() asm volatile("s_waitcnt lgkmcnt(0)" ::: "memory")
__device__ __forceinline__ unsigned f2bf(float f) { unsigned u = __builtin_bit_cast(unsigned, f); return (u + 0x7fffu + ((u >> 16) & 1u)) >> 16; }
__device__ __forceinline__ unsigned pk2(float lo, float hi) { return f2bf(lo) | (f2bf(hi) << 16); }
__device__ __forceinline__ float bflo(unsigned u) { return __builtin_bit_cast(float, u << 16); }
__device__ __forceinline__ float bfhi(unsigned u) { return __builtin_bit_cast(float, u & 0xffff0000u); }
typedef float f32x2_t __attribute__((ext_vector_type(2))); typedef __bf16 bf16x2_t __attribute__((ext_vector_type(2)));
__device__ __forceinline__ unsigned cvt_pk_bf16(float lo, float hi) { f32x2_t v = {lo, hi}; bf16x2_t b = __builtin_convertvector(v, bf16x2_t); return __builtin_bit_cast(unsigned, b); }
__device__ __forceinline__ float clamp_f8(float x) { return __builtin_amdgcn_fmed3f(x, -448.f, 448.f); }
__device__ __forceinline__ unsigned pk4_fp8(float a, float b, float c, float d) { int w = __builtin_amdgcn_cvt_pk_fp8_f32(clamp_f8(a), clamp_f8(b), 0, false); w = __builtin_amdgcn_cvt_pk_fp8_f32(clamp_f8(c), clamp_f8(d), w, true); return (unsigned)w; }
constexpr float W13_SCALE = 32.f, W2_SCALE = 64.f;
__device__ __forceinline__ float wave_sum(float v) {
#pragma unroll
    for (int o = 1; o < 64; o <<= 1) v += __shfl_xor(v, o);
    return v;
}
__device__ __forceinline__ float fast_exp2(float x) { return __builtin_amdgcn_exp2f(x); }
__device__ __forceinline__ float fast_rcp(float x) { return __builtin_amdgcn_rcpf(x); }
__device__ __forceinline__ float sigmoidf_(float x) { return fast_rcp(1.f + fast_exp2(-x * LOG2E)); }

namespace pg8 {
constexpr int BM = 256, BK = 64, HALF = 128, HTB = HALF * BK * 2, NXCD = 8, WGM = 8;
__host__ __device__ __forceinline__ int lds_byte(int r, int c) { const int st = (r >> 4) * 2 + (c >> 5), rr = r & 15, cc = c & 31, ob = rr * 64 + cc * 2; return st * 1024 + (ob ^ (((ob >> 9) & 1) << 5)); }
__host__ __device__ __forceinline__ void stage_rc(int b, int& R, int& C) { const int st = b / 1024, sb = b % 1024, swz = sb ^ (((sb >> 9) & 1) << 5); R = (st >> 1) * 16 + swz / 64; C = (st & 1) * 32 + (swz % 64) / 2; }
__host__ __device__ __forceinline__ int perm32(int rho) { const int n = rho >> 4, i = rho & 15; return 8 * (i >> 2) + 4 * n + (i & 3); }
struct Unit { int pm, pn, aux; };
struct Gemm { int K; int lda; int ldb; };

struct StaticOrder {
    int nM, nN, nwg, G, c;
    __device__ void init(int M, int N, int G_, int c_) { nM = M / BM; nN = N / BM; nwg = nM * nN; G = G_; c = c_; }
    __device__ bool next(int i, Unit& u) const {
        const long L = (long)i * G + c; if (L >= nwg) return false;
        int wgid = (int)L; { const int q = nwg / NXCD, r = nwg % NXCD, xcd = wgid % NXCD, off = wgid / NXCD; wgid = (xcd < r ? xcd * (q + 1) : r * (q + 1) + (xcd - r) * q) + off; }
        const int nig = WGM * nN, gid = wgid / nig, fm = gid * WGM, gsz = (nM - fm) < WGM ? (nM - fm) : WGM;
        u.pm = fm + ((wgid % nig) % gsz); u.pn = (wgid % nig) / gsz; return true;
    }
};

__device__ __forceinline__ i32x8 cat8(const bf16x8& lo, const bf16x8& hi) { return __builtin_shufflevector(__builtin_bit_cast(i32x4, lo), __builtin_bit_cast(i32x4, hi), 0, 1, 2, 3, 4, 5, 6, 7); }
__device__ __forceinline__ void mfma_f8(f32x4& acc, const i32x8 a, const i32x8 b) { asm volatile("v_mfma_f32_16x16x128_f8f6f4 %0, %1, %2, %0" : "+v"(acc) : "v"(a), "v"(b)); }
__device__ __forceinline__ void mfma_f8_drain() { asm volatile("s_nop 7\n\ts_nop 7\n\ts_nop 7" ::: "memory"); }
template <bool F8 = false, class Epi, class Sched>
__device__ __forceinline__ void gemm_phase(LAS unsigned char* lds, const Gemm g, const Sched& S, const Epi& E) {
    int tid = threadIdx.x; asm volatile("" : "+v"(tid));
    const int wid = __builtin_amdgcn_readfirstlane(tid >> 6), lane = tid & 63, wr = wid >> 2, wc = wid & 3, fr = lane & 15, fq = lane >> 4;
    const int K = g.K, lda = g.lda, ldb = g.ldb, nt = K / BK;
    unsigned voffA[2], voffB[2];
#pragma unroll
    for (int i = 0; i < 2; ++i) { int R, C; stage_rc(tid * 16 + i * 8192, R, C); const int Rb = (R & ~31) + perm32(R & 31);
        voffA[i] = (unsigned)(R * lda + C) * 2u; voffB[i] = (unsigned)(Rb * ldb + C) * 2u; }
    const size_t kstep = (size_t)(BK * 2);
    const size_t hstepA = (size_t)HALF * lda * 2, hstepB = (size_t)HALF * ldb * 2;
    const unsigned ldsw = (unsigned)wid * 1024u;
    const int aoff = lds_byte(wr * 64 + fr, fq * 8), boff = lds_byte(wc * 32 + fr, fq * 8);
#define PG8_SA(b, h) (((b) * 2 + (h)) * HTB)
#define PG8_SB(b, h) ((4 + (b) * 2 + (h)) * HTB)
#define PG8_STAGE(bufoff, gbase, voff) do { _Pragma("unroll") for (int _i = 0; _i < 2; ++_i) \
        __builtin_amdgcn_global_load_lds((const unsigned*)((const char*)(gbase) + (voff)[_i]), (LAS unsigned*)(lds + (bufoff) + ldsw + _i * 8192), 16, 0, 0); } while (0)
#define PG8_LDA(dst, b, h) do { _Pragma("unroll") for (int m = 0; m < 4; ++m) _Pragma("unroll") for (int k = 0; k < 2; ++k) dst[m][k] = *(const LAS bf16x8*)(lds + PG8_SA(b, h) + aoff + m * 2048 + k * 1024); } while (0)
#define PG8_LDB(dst, b, h) do { _Pragma("unroll") for (int n = 0; n < 2; ++n) _Pragma("unroll") for (int k = 0; k < 2; ++k) dst[n][k] = *(const LAS bf16x8*)(lds + PG8_SB(b, h) + boff + n * 2048 + k * 1024); } while (0)
#define PG8_MMA(ai, bj, At, Bt) do { __builtin_amdgcn_s_setprio(1); _Pragma("unroll") for (int m = 0; m < 4; ++m) _Pragma("unroll") for (int n = 0; n < 2; ++n) { \
        if constexpr (F8) mfma_f8(acc[ai][bj][m][n], cat8(Bt[n][0], Bt[n][1]), cat8(At[m][0], At[m][1])); \
        else { _Pragma("unroll") for (int k = 0; k < 2; ++k) acc[ai][bj][m][n] = __builtin_amdgcn_mfma_f32_16x16x32_bf16(Bt[n][k], At[m][k], acc[ai][bj][m][n], 0, 0, 0); } } __builtin_amdgcn_s_setprio(0); } while (0)
#define PG8_WAIT_V(n) asm volatile("s_waitcnt vmcnt(" #n ")" ::: "memory")
#define PG8_WAIT_L(n) asm volatile("s_waitcnt lgkmcnt(" #n ")" ::: "memory")
#define PG8_BAR __builtin_amdgcn_s_barrier()
#define PG8_SCHED __builtin_amdgcn_sched_barrier(0)
    Unit cur, nxt; int ui = 0;
    if (!S.next(0, cur)) return;
    f32x4 acc[2][2][4][2];
#pragma unroll
    for (int a = 0; a < 2; ++a)
#pragma unroll
        for (int b = 0; b < 2; ++b)
#pragma unroll
            for (int m = 0; m < 4; ++m)
#pragma unroll
                for (int n = 0; n < 2; ++n) acc[a][b][m][n] = (f32x4){0.f, 0.f, 0.f, 0.f};
    bf16x8 At[4][2], B0[2][2], B1[2][2];
    const char* cA; const char* cB; S.bases(cur, cA, cB);
    PG8_STAGE(PG8_SB(0, 0), cB, voffB); PG8_STAGE(PG8_SB(0, 1), cB + hstepB, voffB); PG8_STAGE(PG8_SA(0, 0), cA, voffA); PG8_STAGE(PG8_SA(0, 1), cA + hstepA, voffA);
    if (wr == 1) PG8_BAR;
    PG8_WAIT_V(2); PG8_BAR;
    PG8_STAGE(PG8_SB(1, 0), cB + kstep, voffB); PG8_STAGE(PG8_SA(1, 0), cA + kstep, voffA); PG8_STAGE(PG8_SB(1, 1), cB + hstepB + kstep, voffB);
    PG8_WAIT_V(6); PG8_BAR;
    for (;;) {
        const bool has_next = S.next(ui + 1, nxt);
        const char* nA = cA; const char* nB = cB; if (has_next) S.bases(nxt, nA, nB);
        for (int t = 0; t < nt; t += 2) {
            const bool last = (t == nt - 2);
            const char* a1 = cA + (size_t)(t + 1) * kstep;
            const char* a2 = last ? nA : cA + (size_t)(t + 2) * kstep; const char* b2 = last ? nB : cB + (size_t)(t + 2) * kstep;
            const char* a3 = a2 + kstep; const char* b3 = b2 + kstep;
            PG8_LDB(B0, 0, 0); PG8_LDB(B1, 0, 1); PG8_SCHED; PG8_LDA(At, 0, 0); PG8_STAGE(PG8_SA(1, 1), a1 + hstepA, voffA);
            PG8_WAIT_V(8); PG8_WAIT_L(0); PG8_BAR; PG8_MMA(0, 0, At, B0); PG8_MMA(0, 1, At, B1); PG8_BAR; PG8_SCHED;
            PG8_LDA(At, 0, 1); PG8_STAGE(PG8_SB(0, 0), b2, voffB); PG8_STAGE(PG8_SB(0, 1), b2 + hstepB, voffB); PG8_STAGE(PG8_SA(0, 0), a2, voffA);
            PG8_WAIT_V(8); PG8_WAIT_L(0); PG8_BAR; PG8_MMA(1, 0, At, B0); PG8_MMA(1, 1, At, B1); PG8_BAR; PG8_SCHED;
            PG8_LDB(B0, 1, 0); PG8_LDB(B1, 1, 1); PG8_SCHED; PG8_LDA(At, 1, 0); PG8_STAGE(PG8_SA(0, 1), a2 + hstepA, voffA);
            PG8_WAIT_V(8); PG8_WAIT_L(0); PG8_BAR; PG8_MMA(0, 0, At, B0); PG8_MMA(0, 1, At, B1); PG8_BAR; PG8_SCHED;
            PG8_LDA(At, 1, 1); PG8_STAGE(PG8_SB(1, 0), b3, voffB); PG8_STAGE(PG8_SB(1, 1), b3 + hstepB, voffB); PG8_STAGE(PG8_SA(1, 0), a3, voffA);
            PG8_WAIT_V(8); PG8_WAIT_L(0); PG8_BAR; PG8_MMA(1, 0, At, B0); PG8_MMA(1, 1, At, B1); PG8_BAR; PG8_SCHED;
            if constexpr (Epi::SEG > 0) { if ((t + 2) % Epi::SEG == 0 && t + 2 < nt) { E.segment(acc, cur, (t + 2) / Epi::SEG - 1, wr, wc, fr, fq); PG8_SCHED; } }
        }
        if (wr == 0) PG8_BAR;
        if constexpr (F8) mfma_f8_drain();
        E(acc, cur, wr, wc, fr, fq);
        if (!has_next) break;
#pragma unroll
        for (int a = 0; a < 2; ++a)
#pragma unroll
            for (int b = 0; b < 2; ++b)
#pragma unroll
                for (int m = 0; m < 4; ++m)
#pragma unroll
                    for (int n = 0; n < 2; ++n) acc[a][b][m][n] = (f32x4){0.f, 0.f, 0.f, 0.f};
        cur = nxt; cA = nA; cB = nB; ++ui;
        if (wr == 1) PG8_BAR;
    }
    PG8_WAIT_V(0);
    PG8_BAR;
#undef PG8_SA
#undef PG8_SB
#undef PG8_STAGE
#undef PG8_LDA
#undef PG8_LDB
#undef PG8_MMA
#undef PG8_WAIT_V
#undef PG8_WAIT_L
#undef PG8_BAR
#undef PG8_SCHED
}
}
using pg8::Unit;

struct SchedStd {
    pg8::StaticOrder so; const char* A; const char* B; size_t tA, tB;
    __device__ void init(int M, int N, int G, int c, const void* A_, int lda, const void* B_, int K) { so.init(M, N, G, c); A = (const char*)A_; B = (const char*)B_; tA = (size_t)256 * lda * 2; tB = (size_t)256 * K * 2; }
    __device__ __forceinline__ bool next(int i, Unit& u) const { u.aux = 0; return so.next(i, u); }
    __device__ __forceinline__ void bases(const Unit& u, const char*& a, const char*& b) const { a = A + (size_t)u.pm * tA; b = B + (size_t)u.pn * tB; }
};
struct SchedCols {
    pg8::StaticOrder so; const char* A; const char* B; size_t tA, tB; int pn0, split, skip;
    __device__ void init(int M, int ntiles, int G, int c, const void* A_, int lda, const void* B_, int K, int pn0_, int split_, int skip_) { so.init(M, ntiles * 256, G, c); A = (const char*)A_; B = (const char*)B_; tA = (size_t)256 * lda * 2; tB = (size_t)256 * K * 2; pn0 = pn0_; split = split_; skip = skip_; }
    __device__ __forceinline__ bool next(int i, Unit& u) const { u.aux = 0; if (!so.next(i, u)) return false; u.pn = u.pn < split ? u.pn + pn0 : u.pn + pn0 + skip; return true; }
    __device__ __forceinline__ void bases(const Unit& u, const char*& a, const char*& b) const { a = A + (size_t)u.pm * tA; b = B + (size_t)u.pn * tB; }
};
struct SchedMoe {
    pg8::StaticOrder so; const char* A; const char* B; size_t tA, tB; int nN; int pst[NEXP];
    __device__ void init(int npan, int N, int G, int c, const void* A_, int lda, const void* B_, int K, const int* pst_) { so.init(npan * 256, N, G, c); nN = N / 256; A = (const char*)A_; B = (const char*)B_; tA = (size_t)256 * lda * 2; tB = (size_t)256 * K * 2;
#pragma unroll
        for (int e = 0; e < NEXP; ++e) pst[e] = pst_[e]; }
    __device__ __forceinline__ bool next(int i, Unit& u) const { if (!so.next(i, u)) return false; int e = 0;
#pragma unroll
        for (int j = 1; j < NEXP; ++j) e += (u.pm >= pst[j]) ? 1 : 0;
        u.aux = e; return true; }
    __device__ __forceinline__ void bases(const Unit& u, const char*& a, const char*& b) const { a = A + (size_t)u.pm * tA; b = B + ((size_t)u.aux * nN + u.pn) * tB; }
};

struct SchedMoeSplit {
    const char* A; const char* B; int p0, nun, G, c; int pst[NEXP];
    __device__ void init(int p0_, int pl, int G_, int c_, const void* A_, const void* B_, const int* pst_) { p0 = p0_; nun = pl * 8; G = G_; c = c_; A = (const char*)A_; B = (const char*)B_;
#pragma unroll
        for (int e = 0; e < NEXP; ++e) pst[e] = pst_[e]; }
    __device__ __forceinline__ bool next(int i, Unit& u) const { const int L = i * G + c; if (L >= nun) return false; u.pn = (L >> 1) & 3; u.pm = p0 + (L >> 3); int e = 0;
#pragma unroll
        for (int j = 1; j < NEXP; ++j) e += (u.pm >= pst[j]) ? 1 : 0;
        u.aux = e + 8 * (L & 1); return true; }
    __device__ __forceinline__ void bases(const Unit& u, const char*& a, const char*& b) const { const int ks = u.aux >> 3, e = u.aux & 7;
        a = A + (size_t)u.pm * (256 * DFE) + ks * (DFE / 2); b = B + ((size_t)e * 4 + u.pn) * (256 * DFE) + ks * (DFE / 2); }
};

typedef f32x4 AccT[2][2][4][2];
__device__ __forceinline__ u32x4 pack8(const f32x4& v0, const f32x4& v1) { u32x4 w; w.x = cvt_pk_bf16(v0[0], v0[1]); w.y = cvt_pk_bf16(v0[2], v0[3]); w.z = cvt_pk_bf16(v1[0], v1[1]); w.w = cvt_pk_bf16(v1[2], v1[3]); return w; }

__device__ __forceinline__ float sig255(float acc, float nsc) { const float e = fast_exp2(fminf(acc * nsc, 7.98f)); return fast_rcp(__builtin_fmaf(e, 1.f / 255.f, 1.f / 255.f)); }
__device__ __forceinline__ unsigned pk4_u8(float a, float b, float c, float d) { unsigned w = __builtin_amdgcn_cvt_pk_u8_f32(a, 0, 0u); w = __builtin_amdgcn_cvt_pk_u8_f32(b, 1, w); w = __builtin_amdgcn_cvt_pk_u8_f32(c, 2, w); return __builtin_amdgcn_cvt_pk_u8_f32(d, 3, w); }
struct EpiProj {
    static constexpr int SEG = 0;
    bf16* O; int ldc; float s0; int npn0; float gsc;
    __device__ __forceinline__ void operator()(const AccT& acc, const Unit& u, int wr, int wc, int fr, int fq) const {
        const int row0 = u.pm * 256 + wr * 64 + fr, col0 = u.pn * 256 + wc * 32 + 8 * fq; const float sc = (u.pn < npn0) ? s0 : 1.f;
        if (u.pn >= C_GATE / 256 && u.pn < (C_GATE + 4096) / 256) {
            unsigned char* gbase = (unsigned char*)(O + C_GATE) + (col0 - C_GATE);
#pragma unroll
            for (int ai = 0; ai < 2; ++ai)
#pragma unroll
                for (int m = 0; m < 4; ++m) { unsigned char* rowp = gbase + (size_t)(row0 + ai * 128 + m * 16) * (ldc * 2);
#pragma unroll
                    for (int bj = 0; bj < 2; ++bj) { const f32x4 a = acc[ai][bj][m][0], b = acc[ai][bj][m][1]; u32x2 w;
                        const float nsc = -gsc * LOG2E;
                        w.x = pk4_u8(sig255(a[0], nsc), sig255(a[1], nsc), sig255(a[2], nsc), sig255(a[3], nsc));
                        w.y = pk4_u8(sig255(b[0], nsc), sig255(b[1], nsc), sig255(b[2], nsc), sig255(b[3], nsc));
                        *(u32x2*)(rowp + bj * 128) = w; } }
            return;
        }
#pragma unroll
        for (int ai = 0; ai < 2; ++ai)
#pragma unroll
            for (int m = 0; m < 4; ++m) { bf16* rowp = O + (size_t)(row0 + ai * 128 + m * 16) * ldc + col0;
#pragma unroll
                for (int bj = 0; bj < 2; ++bj) *(u32x4*)(rowp + bj * 128) = pack8(acc[ai][bj][m][0] * sc, acc[ai][bj][m][1] * sc); }
    }
};
struct EpiRowScale {
    static constexpr int SEG = 0;
    bf16* O; int ldc; const float* rs; int rstride; float mul;
    __device__ __forceinline__ void operator()(const AccT& acc, const Unit& u, int wr, int wc, int fr, int fq) const {
        const int row0 = u.pm * 256 + wr * 64 + fr, col0 = u.pn * 256 + wc * 32 + 8 * fq;
#pragma unroll
        for (int ai = 0; ai < 2; ++ai)
#pragma unroll
            for (int m = 0; m < 4; ++m) { const int row = row0 + ai * 128 + m * 16; const float sc = rs ? rs[(size_t)row * rstride] * mul : mul; bf16* rowp = O + (size_t)row * ldc + col0;
#pragma unroll
                for (int bj = 0; bj < 2; ++bj) *(u32x4*)(rowp + bj * 128) = pack8(acc[ai][bj][m][0] * sc, acc[ai][bj][m][1] * sc); }
    }
};
__device__ __forceinline__ float g8(unsigned b) { return (float)b; }
struct EpiMergeCat {
    static constexpr int SEG = 8;
    bf16* MG; const unsigned char* GATE8;
    __device__ __forceinline__ void segment(AccT& acc, const Unit& u, int sgi, int wr, int wc, int fr, int fq) const {
        const int row0 = u.pm * 256 + wr * 64 + fr, col0 = u.pn * 256 + wc * 32 + 8 * fq;
#pragma unroll
        for (int bj = 0; bj < 2; ++bj)
#pragma unroll
        for (int ai = 0; ai < 2; ++ai) { const int col = col0 + bj * 128; u32x2 ga[4], gb[4];
#pragma unroll
            for (int m = 0; m < 4; ++m) { const unsigned go = (unsigned)(row0 + ai * 128 + m * 16) * (unsigned)(NPROJ * 2) + (unsigned)(sgi * 1024 + col); ga[m] = *(const u32x2*)(GATE8 + go); gb[m] = *(const u32x2*)(GATE8 + go + 1024u); }
#pragma unroll
            for (int m = 0; m < 4; ++m) { const u32x2 a = ga[m], b = gb[m];
                f32x4& v0 = acc[ai][bj][m][0]; f32x4& v1 = acc[ai][bj][m][1];
                v0[0] *= g8(a.x & 255u) * fast_rcp(g8(b.x & 255u)); v0[1] *= g8((a.x >> 8) & 255u) * fast_rcp(g8((b.x >> 8) & 255u)); v0[2] *= g8((a.x >> 16) & 255u) * fast_rcp(g8((b.x >> 16) & 255u)); v0[3] *= g8(a.x >> 24) * fast_rcp(g8(b.x >> 24));
                v1[0] *= g8(a.y & 255u) * fast_rcp(g8(b.y & 255u)); v1[1] *= g8((a.y >> 8) & 255u) * fast_rcp(g8((b.y >> 8) & 255u)); v1[2] *= g8((a.y >> 16) & 255u) * fast_rcp(g8((b.y >> 16) & 255u)); v1[3] *= g8(a.y >> 24) * fast_rcp(g8(b.y >> 24)); }
            asm volatile("" ::: "memory"); __builtin_amdgcn_sched_barrier(0);
        }
    }
    __device__ __forceinline__ void operator()(const AccT& acc, const Unit& u, int wr, int wc, int fr, int fq) const {
        const int row0 = u.pm * 256 + wr * 64 + fr, col0 = u.pn * 256 + wc * 32 + 8 * fq; constexpr float I255 = 1.f / 255.f;
#pragma unroll
        for (int bj = 0; bj < 2; ++bj)
#pragma unroll
        for (int ai = 0; ai < 2; ++ai) { const int col = col0 + bj * 128; u32x2 gw[4];
#pragma unroll
            for (int m = 0; m < 4; ++m) gw[m] = *(const u32x2*)(GATE8 + ((unsigned)(row0 + ai * 128 + m * 16) * (unsigned)(NPROJ * 2) + (unsigned)(3 * 1024 + col)));
#pragma unroll
            for (int m = 0; m < 4; ++m) { const int row = row0 + ai * 128 + m * 16; const u32x2 g = gw[m];
                f32x4 v0 = acc[ai][bj][m][0], v1 = acc[ai][bj][m][1];
                v0[0] *= g8(g.x & 255u) * I255; v0[1] *= g8((g.x >> 8) & 255u) * I255; v0[2] *= g8((g.x >> 16) & 255u) * I255; v0[3] *= g8(g.x >> 24) * I255;
                v1[0] *= g8(g.y & 255u) * I255; v1[1] *= g8((g.y >> 8) & 255u) * I255; v1[2] *= g8((g.y >> 16) & 255u) * I255; v1[3] *= g8(g.y >> 24) * I255;
                *(u32x4*)(MG + (size_t)row * 1024 + col) = pack8(v0, v1); }
            asm volatile("" ::: "memory");
        }
    }
};
struct EpiSplitF32 {
    static constexpr int SEG = 0;
    float* SLAB; const float* rs; int row_base; float mul;
    __device__ __forceinline__ void operator()(const AccT& acc, const Unit& u, int wr, int wc, int fr, int fq) const {
        const int row0 = u.pm * 256 + wr * 64 + fr, col0 = u.pn * 256 + wc * 32 + 8 * fq; float* sl = SLAB + (size_t)(u.aux >> 3) * (8 * 256 * 1024);
#pragma unroll
        for (int ai = 0; ai < 2; ++ai)
#pragma unroll
            for (int m = 0; m < 4; ++m) { const int row = row0 + ai * 128 + m * 16; const float sc = rs[row] * mul; float* rowp = sl + (size_t)(row - row_base) * 1024 + col0;
#pragma unroll
                for (int bj = 0; bj < 2; ++bj) { *(f32x4*)(rowp + bj * 128) = acc[ai][bj][m][0] * sc; *(f32x4*)(rowp + bj * 128 + 4) = acc[ai][bj][m][1] * sc; } }
    }
};
struct EpiSwiglu {
    static constexpr int SEG = 0;
    bf16* H; int ldh;
    __device__ __forceinline__ void operator()(const AccT& acc, const Unit& u, int wr, int wc, int fr, int fq) const {
        const int row0 = u.pm * 256 + wr * 64 + fr, col0 = u.pn * 128 + wc * 32 + 8 * fq;
#pragma unroll
        for (int ai = 0; ai < 2; ++ai)
#pragma unroll
            for (int m = 0; m < 4; ++m) { const int row = row0 + ai * 128 + m * 16; f32x4 v[2];
#pragma unroll
                for (int n = 0; n < 2; ++n)
#pragma unroll
                    for (int e = 0; e < 4; ++e) { const float a = acc[ai][0][m][n][e]; v[n][e] = a * sigmoidf_(a) * acc[ai][1][m][n][e]; }
                *(u32x4*)(H + (size_t)row * ldh + col0) = pack8(v[0], v[1]); }
    }
};

struct EpiSwigluF8 {
    static constexpr int SEG = 0;
    unsigned char* H; int ldh; float s;
    __device__ __forceinline__ void operator()(const AccT& acc, const Unit& u, int wr, int wc, int fr, int fq) const {
        const int row0 = u.pm * 256 + wr * 64 + fr, col0 = u.pn * 128 + wc * 32 + 8 * fq; const float nsc = -s * LOG2E, k2 = 1.f / (s * s);
#pragma unroll
        for (int ai = 0; ai < 2; ++ai)
#pragma unroll
            for (int m = 0; m < 4; ++m) { const int row = row0 + ai * 128 + m * 16; f32x4 v[2];
#pragma unroll
                for (int n = 0; n < 2; ++n)
#pragma unroll
                    for (int e = 0; e < 4; ++e) { const float A = acc[ai][0][m][n][e], ex = fast_exp2(A * nsc); v[n][e] = (A * acc[ai][1][m][n][e]) * fast_rcp(__builtin_fmaf(ex, k2, k2)); }
                u32x2 w; w.x = pk4_fp8(v[0][0], v[0][1], v[0][2], v[0][3]); w.y = pk4_fp8(v[1][0], v[1][1], v[1][2], v[1][3]);
                *(u32x2*)(H + (size_t)row * ldh + col0) = w; }
    }
};

namespace att {
constexpr int KSTR = 208, VSTR = 144, KT_BYTES = 64 * KSTR, VT_BYTES = 64 * VSTR, V_OFF = 3 * KT_BYTES, RPB_OFF = V_OFF + 2 * VT_BYTES;
constexpr float NEG = -1e30f;
template <int DQK, bool NA, bool ROPE, int DBG = 0>
__device__ __forceinline__ void attn_unit(LAS unsigned char* lds, const bf16* __restrict__ Qw, int ldq, const bf16* __restrict__ Kb, int ldk, const bf16* __restrict__ Vb, int ldv,
                                          const bf16* __restrict__ KRb, bf16* Ow, int ldo, int nloc, int loc0, int ctx0, int nt, int wst, int drow0, int cq, int tq0, const float* __restrict__ ctab) {
    int tid = threadIdx.x; asm volatile("" : "+v"(tid));
    const int lane = tid & 63, q = lane & 31, h = lane >> 5;
    constexpr int NK = DQK / 16;
    bf16x8 qf[NK];
#pragma unroll
    for (int kk = 0; kk < NK; ++kk) qf[kk] = *(const bf16x8*)(Qw + (size_t)q * ldq + kk * 16 + h * 8);
    if constexpr (ROPE) {
        const int tq = tq0 + q;
#pragma unroll
        for (int k2 = 0; k2 < 2; ++k2) { const int pos = k2 == 0 ? (tq >> 6) : (tq & 63); const f32x4 cs = *(const f32x4*)(ctab + pos * 8 + 4 * h), sn = *(const f32x4*)(ctab + 1024 + pos * 8 + 4 * h);
            u32x4 w = __builtin_bit_cast(u32x4, qf[4 + k2]);
#pragma unroll
            for (int i = 0; i < 4; ++i) { const float x0 = bflo(w[i]), x1 = bfhi(w[i]); w[i] = pk2(x0 * cs[i] - x1 * sn[i], x0 * sn[i] + x1 * cs[i]); }
            qf[4 + k2] = __builtin_bit_cast(bf16x8, w); }
    }
    float lsum = 0.f; f32x16 o0 = {}, o1 = {};
    f32x16 negm = {};
    const int kkey = tid >> 3, kc = tid & 7, vkey = tid & 63, vc = tid >> 6, rkey = (tid >> 2) & 63, rc = tid & 3;
    const int pk = (q & 3) | (((q >> 3) & 1) << 2) | (((q >> 2) & 1) << 3) | (q & 16);
    const LAS float* rpbL = (const LAS float*)(lds + RPB_OFF);
    const LAS unsigned char* kfr = lds + pk * KSTR + h * 16;
    const LAS unsigned char* vfr = lds + V_OFF + q * VSTR + h * 16;
    int cs_ = cq - 8; cs_ = cs_ < 0 ? 0 : (cs_ > 48 ? 48 : cs_);
    u32x4 rk = {0u, 0u, 0u, 0u}, rv = {0u, 0u, 0u, 0u}, rr = {0u, 0u, 0u, 0u};
#define ATT_ROW(t) (((t) < nloc) ? loc0 + 64 * (t) : ctx0 + 64 * ((t) - nloc))
#define ATT_LOADK(t) do { const int r0_ = ATT_ROW(t); rk = *(const u32x4*)(Kb + (size_t)(r0_ + kkey) * ldk + 8 * kc); if (DQK == 96 && tid < 256) rr = *(const u32x4*)(KRb + (size_t)(r0_ + rkey) * 32 + 8 * rc); } while (0)
#define ATT_LOADV(t) do { const int r0_ = ATT_ROW(t); rv = *(const u32x4*)(Vb + (size_t)(r0_ + vkey) * ldv + 8 * vc); } while (0)
#define ATT_STOREK(ks_) do { LAS unsigned char* kb_ = lds + (ks_) * KT_BYTES; *(LAS u32x4*)(kb_ + kkey * KSTR + kc * 16) = rk; if (DQK == 96 && tid < 256) *(LAS u32x4*)(kb_ + rkey * KSTR + 128 + rc * 16) = rr; } while (0)
#define ATT_STOREV(vs_) do { LAS unsigned short* vt_ = (LAS unsigned short*)(lds + V_OFF + (vs_) * VT_BYTES) + (8 * vc) * (VSTR / 2) + vkey; \
        vt_[0 * (VSTR / 2)] = (unsigned short)(rv.x & 0xffffu); vt_[1 * (VSTR / 2)] = (unsigned short)(rv.x >> 16); vt_[2 * (VSTR / 2)] = (unsigned short)(rv.y & 0xffffu); vt_[3 * (VSTR / 2)] = (unsigned short)(rv.y >> 16); \
        vt_[4 * (VSTR / 2)] = (unsigned short)(rv.z & 0xffffu); vt_[5 * (VSTR / 2)] = (unsigned short)(rv.z >> 16); vt_[6 * (VSTR / 2)] = (unsigned short)(rv.w & 0xffffu); vt_[7 * (VSTR / 2)] = (unsigned short)(rv.w >> 16); } while (0)
#define ATT_ACTIVE(t) (!(NA && (t) < nloc) || ((t) >= wst && (t) < wst + 8))
#define ATT_QK(P0, P1, ks_) do { const LAS unsigned char* kb_ = kfr + (ks_) * KT_BYTES; \
        _Pragma("unroll") for (int kh = 0; kh < 2; ++kh) { bf16x8 ka_[NK / 2], kb2_[NK / 2]; \
            _Pragma("unroll") for (int kk = 0; kk < NK / 2; ++kk) { ka_[kk] = *(const LAS bf16x8*)(kb_ + (kh * (NK / 2) + kk) * 32); kb2_[kk] = *(const LAS bf16x8*)(kb_ + 32 * KSTR + (kh * (NK / 2) + kk) * 32); } \
            _Pragma("unroll") for (int kk = 0; kk < NK / 2; ++kk) { \
                if (kh == 0 && kk == 0) { P0 = __builtin_amdgcn_mfma_f32_32x32x16_bf16(ka_[0], qf[0], negm, 0, 0, 0); P1 = __builtin_amdgcn_mfma_f32_32x32x16_bf16(kb2_[0], qf[0], negm, 0, 0, 0); } \
                else { P0 = __builtin_amdgcn_mfma_f32_32x32x16_bf16(ka_[kk], qf[kh * (NK / 2) + kk], P0, 0, 0, 0); P1 = __builtin_amdgcn_mfma_f32_32x32x16_bf16(kb2_[kk], qf[kh * (NK / 2) + kk], P1, 0, 0, 0); } } } } while (0)
#define ATT_STEP(PC0, PC1, PN0, PN1, t, HASN) do { \
        if (DBG != 2) { if ((t) + 2 < nt) ATT_LOADK((t) + 2); \
        if ((t) + 1 < nt) ATT_LOADV((t) + 1); } \
        const bool act_ = ATT_ACTIVE(t); \
        if (act_) { \
            if (NA && (t) < nloc) { const LAS float* brow = rpbL + (drow0 + (t)) * 31 + 15 - cq; \
                _Pragma("unroll") for (int r = 0; r < 16; ++r) { const int kc0 = 16 * (r >> 3) + 8 * h + (r & 7), kc1 = kc0 + 32; \
                    PC0[r] = ((unsigned)(kc0 - cs_) < 16u) ? PC0[r] + brow[kc0] : NEG; PC1[r] = ((unsigned)(kc1 - cs_) < 16u) ? PC1[r] + brow[kc1] : NEG; } } \
            float mx = 0.f; if (DBG != 1) { \
            float m0_ = fmaxf(fmaxf(PC0[0], PC0[1]), PC0[2]), m1_ = fmaxf(fmaxf(PC1[0], PC1[1]), PC1[2]); \
            _Pragma("unroll") for (int r = 3; r < 15; r += 2) { m0_ = fmaxf(fmaxf(m0_, PC0[r]), PC0[r + 1]); m1_ = fmaxf(fmaxf(m1_, PC1[r]), PC1[r + 1]); } \
            mx = fmaxf(fmaxf(m0_, PC0[15]), fmaxf(m1_, PC1[15])); \
            mx = fmaxf(mx, __shfl_xor(mx, 32)); } \
            if (__any(mx > 8.f)) { const float dl = fmaxf(mx, 0.f), al = fast_exp2(-dl); lsum *= al; \
                _Pragma("unroll") for (int r = 0; r < 16; ++r) { o0[r] *= al; o1[r] *= al; PC0[r] -= dl; PC1[r] -= dl; negm[r] -= dl; } } \
        } \
        if (HASN) { if (ATT_ACTIVE((t) + 1)) ATT_QK(PN0, PN1, ((t) + 1) % 3); } \
        if (act_) { \
            const LAS unsigned char* vb_ = vfr + ((t) & 1) * VT_BYTES; \
            float sacc = 0.f; \
            if (DBG != 1) { _Pragma("unroll") for (int r = 0; r < 16; ++r) { PC0[r] = fast_exp2(PC0[r]); PC1[r] = fast_exp2(PC1[r]); sacc += PC0[r] + PC1[r]; } } \
            lsum += sacc; \
            bf16x8 pf[4]; \
            _Pragma("unroll") for (int ks = 0; ks < 2; ++ks) { u32x4 w, w2; \
                w.x = cvt_pk_bf16(PC0[8 * ks + 0], PC0[8 * ks + 1]); w.y = cvt_pk_bf16(PC0[8 * ks + 2], PC0[8 * ks + 3]); w.z = cvt_pk_bf16(PC0[8 * ks + 4], PC0[8 * ks + 5]); w.w = cvt_pk_bf16(PC0[8 * ks + 6], PC0[8 * ks + 7]); \
                w2.x = cvt_pk_bf16(PC1[8 * ks + 0], PC1[8 * ks + 1]); w2.y = cvt_pk_bf16(PC1[8 * ks + 2], PC1[8 * ks + 3]); w2.z = cvt_pk_bf16(PC1[8 * ks + 4], PC1[8 * ks + 5]); w2.w = cvt_pk_bf16(PC1[8 * ks + 6], PC1[8 * ks + 7]); \
                pf[ks] = __builtin_bit_cast(bf16x8, w); pf[2 + ks] = __builtin_bit_cast(bf16x8, w2); } \
            _Pragma("unroll") for (int vh = 0; vh < 2; ++vh) { bf16x8 va_[2], vb2_[2]; \
                _Pragma("unroll") for (int ks = 0; ks < 2; ++ks) { va_[ks] = *(const LAS bf16x8*)(vb_ + (2 * vh + ks) * 32); vb2_[ks] = *(const LAS bf16x8*)(vb_ + 32 * VSTR + (2 * vh + ks) * 32); } \
                _Pragma("unroll") for (int ks = 0; ks < 2; ++ks) { o0 = __builtin_amdgcn_mfma_f32_32x32x16_bf16(va_[ks], pf[2 * vh + ks], o0, 0, 0, 0); o1 = __builtin_amdgcn_mfma_f32_32x32x16_bf16(vb2_[ks], pf[2 * vh + ks], o1, 0, 0, 0); } } \
        } \
        if (DBG != 2) { if ((t) + 2 < nt) ATT_STOREK(((t) + 2) % 3); \
        if ((t) + 1 < nt) ATT_STOREV(((t) + 1) & 1); } \
        if (DBG != 3) __syncthreads(); \
    } while (0)
    f32x16 pA0, pA1, pB0, pB1;
    if (tid >= 256) __builtin_amdgcn_s_setprio(1);
    ATT_LOADK(0); ATT_LOADV(0); ATT_STOREK(0); ATT_STOREV(0);
    if (nt > 1) { ATT_LOADK(1); ATT_STOREK(1); }
    __syncthreads();
    pA0 = (f32x16){}; pA1 = (f32x16){}; pB0 = (f32x16){}; pB1 = (f32x16){};
    if (ATT_ACTIVE(0)) ATT_QK(pA0, pA1, 0);
    int t = 0;
    for (; t + 2 < nt; t += 2) { ATT_STEP(pA0, pA1, pB0, pB1, t, true); ATT_STEP(pB0, pB1, pA0, pA1, t + 1, true); }
    if (t + 2 == nt) { ATT_STEP(pA0, pA1, pB0, pB1, t, true); ATT_STEP(pB0, pB1, pA0, pA1, t + 1, false); }
    else { ATT_STEP(pA0, pA1, pB0, pB1, t, false); }
    __builtin_amdgcn_s_setprio(0);
    lsum += __shfl_xor(lsum, 32);
    const float inv = 1.f / lsum;
    bf16* orow = Ow + (size_t)q * ldo;
#pragma unroll
    for (int g = 0; g < 4; ++g) {
        u32x2 w0, w1; w0.x = cvt_pk_bf16(o0[4 * g] * inv, o0[4 * g + 1] * inv); w0.y = cvt_pk_bf16(o0[4 * g + 2] * inv, o0[4 * g + 3] * inv);
        w1.x = cvt_pk_bf16(o1[4 * g] * inv, o1[4 * g + 1] * inv); w1.y = cvt_pk_bf16(o1[4 * g + 2] * inv, o1[4 * g + 3] * inv);
        *(u32x2*)(orow + 8 * g + 4 * h) = w0; *(u32x2*)(orow + 32 + 8 * g + 4 * h) = w1;
    }
#undef ATT_ROW
#undef ATT_LOADK
#undef ATT_LOADV
#undef ATT_STOREK
#undef ATT_STOREV
#undef ATT_ACTIVE
#undef ATT_QK
#undef ATT_STEP
}

struct NaCtx { int lo, nloc, wa, wb, rws, cs, kb0, qrow, qcol, pk, q, hh; };
__device__ __forceinline__ void na_compute(LAS unsigned char* lds, const NaCtx& c, int t, const bf16x8 (&qf)[4], f32x16& o0, f32x16& o1, f32x16& negm, float& lsum) {
    const LAS float* rpbL = (const LAS float*)(lds + RPB_OFF);
    const LAS unsigned char* kb = lds + (t & 1) * (KT_BYTES + VT_BYTES); const LAS unsigned char* vb = kb + KT_BYTES;
    const int q = c.q, hh = c.hh, pk = c.pk, kb0 = c.kb0;
    if (t < c.nloc) {
        const int kr = c.lo + t;
        if (kr >= c.wa && kr < c.wb + 8) {
            const LAS unsigned char* kf = kb + (kb0 + pk) * KSTR + hh * 16; bf16x8 ka[4];
#pragma unroll
            for (int kk = 0; kk < 4; ++kk) ka[kk] = *(const LAS bf16x8*)(kf + kk * 32);
            f32x16 p0 = __builtin_amdgcn_mfma_f32_32x32x16_bf16(ka[0], qf[0], negm, 0, 0, 0);
#pragma unroll
            for (int kk = 1; kk < 4; ++kk) p0 = __builtin_amdgcn_mfma_f32_32x32x16_bf16(ka[kk], qf[kk], p0, 0, 0, 0);
            bf16x8 va[2], vb2[2];
#pragma unroll
            for (int ks = 0; ks < 2; ++ks) { va[ks] = *(const LAS bf16x8*)(vb + q * VSTR + (kb0 + 16 * ks + 8 * hh) * 2); vb2[ks] = *(const LAS bf16x8*)(vb + (32 + q) * VSTR + (kb0 + 16 * ks + 8 * hh) * 2); }
            const bool rok = (unsigned)(kr - c.rws) < 8u; const LAS float* brow = rpbL + (kr - c.qrow + 7) * 31 + 15 - c.qcol;
            float mx = NEG, bv[16];
#pragma unroll
            for (int r = 0; r < 16; ++r) bv[r] = brow[kb0 + 16 * (r >> 3) + 8 * hh + (r & 7)];
#pragma unroll
            for (int r = 0; r < 16; ++r) { const int kcol = kb0 + 16 * (r >> 3) + 8 * hh + (r & 7);
                p0[r] = (rok && (unsigned)(kcol - c.cs) < 16u) ? p0[r] + bv[r] : NEG; mx = fmaxf(mx, p0[r]); }
            if (__any(mx > 8.f)) { mx = fmaxf(mx, __shfl_xor(mx, 32)); const float dl = fmaxf(mx, 0.f), al = fast_exp2(-dl); lsum *= al;
#pragma unroll
                for (int r = 0; r < 16; ++r) { o0[r] *= al; o1[r] *= al; p0[r] -= dl; negm[r] -= dl; } }
            float sacc = 0.f;
#pragma unroll
            for (int r = 0; r < 16; ++r) { p0[r] = fast_exp2(p0[r]); sacc += p0[r]; }
            lsum += sacc;
#pragma unroll
            for (int ks = 0; ks < 2; ++ks) { u32x4 wv; wv.x = cvt_pk_bf16(p0[8 * ks + 0], p0[8 * ks + 1]); wv.y = cvt_pk_bf16(p0[8 * ks + 2], p0[8 * ks + 3]); wv.z = cvt_pk_bf16(p0[8 * ks + 4], p0[8 * ks + 5]); wv.w = cvt_pk_bf16(p0[8 * ks + 6], p0[8 * ks + 7]);
                const bf16x8 pf = __builtin_bit_cast(bf16x8, wv);
                o0 = __builtin_amdgcn_mfma_f32_32x32x16_bf16(va[ks], pf, o0, 0, 0, 0); o1 = __builtin_amdgcn_mfma_f32_32x32x16_bf16(vb2[ks], pf, o1, 0, 0, 0); }
        }
    } else {
        const LAS unsigned char* kf = kb + pk * KSTR + hh * 16; bf16x8 ka[4], kb2[4];
#pragma unroll
        for (int kk = 0; kk < 4; ++kk) { ka[kk] = *(const LAS bf16x8*)(kf + kk * 32); kb2[kk] = *(const LAS bf16x8*)(kf + 32 * KSTR + kk * 32); }
        f32x16 p0 = __builtin_amdgcn_mfma_f32_32x32x16_bf16(ka[0], qf[0], negm, 0, 0, 0), p1 = __builtin_amdgcn_mfma_f32_32x32x16_bf16(kb2[0], qf[0], negm, 0, 0, 0);
#pragma unroll
        for (int kk = 1; kk < 4; ++kk) { p0 = __builtin_amdgcn_mfma_f32_32x32x16_bf16(ka[kk], qf[kk], p0, 0, 0, 0); p1 = __builtin_amdgcn_mfma_f32_32x32x16_bf16(kb2[kk], qf[kk], p1, 0, 0, 0); }
        float mx = fmaxf(p0[0], p1[0]);
#pragma unroll
        for (int r = 1; r < 16; ++r) mx = fmaxf(mx, fmaxf(p0[r], p1[r]));
        if (__any(mx > 8.f)) { mx = fmaxf(mx, __shfl_xor(mx, 32)); const float dl = fmaxf(mx, 0.f), al = fast_exp2(-dl); lsum *= al;
#pragma unroll
            for (int r = 0; r < 16; ++r) { o0[r] *= al; o1[r] *= al; p0[r] -= dl; p1[r] -= dl; negm[r] -= dl; } }
        float sacc = 0.f;
#pragma unroll
        for (int r = 0; r < 16; ++r) { p0[r] = fast_exp2(p0[r]); p1[r] = fast_exp2(p1[r]); sacc += p0[r] + p1[r]; }
        lsum += sacc;
#pragma unroll
        for (int ks = 0; ks < 4; ++ks) { u32x4 wv;
            if (ks < 2) { wv.x = cvt_pk_bf16(p0[8 * ks + 0], p0[8 * ks + 1]); wv.y = cvt_pk_bf16(p0[8 * ks + 2], p0[8 * ks + 3]); wv.z = cvt_pk_bf16(p0[8 * ks + 4], p0[8 * ks + 5]); wv.w = cvt_pk_bf16(p0[8 * ks + 6], p0[8 * ks + 7]); }
            else { const int bb = 8 * (ks - 2); wv.x = cvt_pk_bf16(p1[bb + 0], p1[bb + 1]); wv.y = cvt_pk_bf16(p1[bb + 2], p1[bb + 3]); wv.z = cvt_pk_bf16(p1[bb + 4], p1[bb + 5]); wv.w = cvt_pk_bf16(p1[bb + 6], p1[bb + 7]); }
            const bf16x8 pf = __builtin_bit_cast(bf16x8, wv);
            const bf16x8 v0 = *(const LAS bf16x8*)(vb + q * VSTR + (16 * ks + 8 * hh) * 2), v1 = *(const LAS bf16x8*)(vb + (32 + q) * VSTR + (16 * ks + 8 * hh) * 2);
            o0 = __builtin_amdgcn_mfma_f32_32x32x16_bf16(v0, pf, o0, 0, 0, 0); o1 = __builtin_amdgcn_mfma_f32_32x32x16_bf16(v1, pf, o1, 0, 0, 0); }
    }
}
__device__ __forceinline__ void na_unit(LAS unsigned char* lds, const bf16* __restrict__ P, bf16* __restrict__ O, int b, int h, int r0) {
    int tid = threadIdx.x; asm volatile("" : "+v"(tid));
    const int lane = tid & 63, q = lane & 31, hh = lane >> 5, w = __builtin_amdgcn_readfirstlane(tid >> 6);
    constexpr int KS2 = 2 * (KT_BYTES + VT_BYTES);
    const int rq0 = r0 + 2 * (w >> 2), c0 = 16 * (w & 3), qrow = rq0 + (q >> 4), qcol = c0 + (q & 15);
    NaCtx c; c.q = q; c.hh = hh; c.qrow = qrow; c.qcol = qcol;
    c.kb0 = c0 - 8 < 0 ? 0 : (c0 - 8 > 32 ? 32 : c0 - 8);
    int lo = r0 - 4; lo = lo < 0 ? 0 : (lo > 120 ? 120 : lo); int hs = r0 - 1; hs = hs < 0 ? 0 : (hs > 120 ? 120 : hs); const int nloc = hs + 7 - lo + 1, nt = nloc + 4; c.lo = lo; c.nloc = nloc;
    int wa = rq0 - 4; wa = wa < 0 ? 0 : (wa > 120 ? 120 : wa); int wb = rq0 - 3; wb = wb < 0 ? 0 : (wb > 120 ? 120 : wb); c.wa = wa; c.wb = wb;
    int rws = qrow - 4; rws = rws < 0 ? 0 : (rws > 120 ? 120 : rws); int cs = qcol - 8; cs = cs < 0 ? 0 : (cs > 48 ? 48 : cs); c.rws = rws; c.cs = cs;
    c.pk = (q & 3) | (((q >> 3) & 1) << 2) | (((q >> 2) & 1) << 3) | (q & 16);
    const size_t qg = (size_t)(b * SEQ + qrow * 64 + qcol);
    bf16x8 qf[4];
#pragma unroll
    for (int kk = 0; kk < 4; ++kk) qf[kk] = *(const bf16x8*)(P + qg * NPROJ + C_QA + h * 64 + kk * 16 + hh * 8);
    const bf16* Kb = P + C_KA + h * 64; const bf16* Vb = P + C_VA + h * 64;
    const int kkey = tid >> 3, kc = tid & 7, vkey = tid & 63, vc = tid >> 6;
    float lsum = 0.f; f32x16 o0 = {}, o1 = {}; f32x16 negm = {};
    u32x4 rkA, rvA, rkB, rvB, rkC, rvC;
#define NA_ROW(t) (((t) < nloc) ? b * SEQ + (lo + (t)) * 64 : TL + b * CTXL + 64 * ((t) - nloc))
#define NA_LOAD(t, RK, RV) do { const int r0_ = NA_ROW(t); RK = *(const u32x4*)(Kb + (size_t)(r0_ + kkey) * NPROJ + 8 * kc); RV = *(const u32x4*)(Vb + (size_t)(r0_ + vkey) * NPROJ + 8 * vc); } while (0)
#define NA_STORE(s_, RK, RV) do { LAS unsigned char* kb_ = lds + (s_) * (KT_BYTES + VT_BYTES); *(LAS u32x4*)(kb_ + kkey * KSTR + kc * 16) = RK; \
        LAS unsigned short* vt_ = (LAS unsigned short*)(kb_ + KT_BYTES) + (8 * vc) * (VSTR / 2) + vkey; \
        vt_[0 * (VSTR / 2)] = (unsigned short)(RV.x & 0xffffu); vt_[1 * (VSTR / 2)] = (unsigned short)(RV.x >> 16); vt_[2 * (VSTR / 2)] = (unsigned short)(RV.y & 0xffffu); vt_[3 * (VSTR / 2)] = (unsigned short)(RV.y >> 16); \
        vt_[4 * (VSTR / 2)] = (unsigned short)(RV.z & 0xffffu); vt_[5 * (VSTR / 2)] = (unsigned short)(RV.z >> 16); vt_[6 * (VSTR / 2)] = (unsigned short)(RV.w & 0xffffu); vt_[7 * (VSTR / 2)] = (unsigned short)(RV.w >> 16); } while (0)
#define NA_STEP(t, LK, LV, SK, SV) do { { const int tl_ = (t) + 3 < nt ? (t) + 3 : nt - 1; NA_LOAD(tl_, LK, LV); } if ((t) < nt) na_compute(lds, c, (t), qf, o0, o1, negm, lsum); NA_STORE(((t) + 1) & 1, SK, SV); __syncthreads(); } while (0)
    static_assert(KS2 <= RPB_OFF, "two stages below the rpb table");
    NA_LOAD(0, rkA, rvA); NA_LOAD(1, rkB, rvB); NA_LOAD(2, rkC, rvC);
    NA_STORE(0, rkA, rvA); __syncthreads();
    for (int t = 0; t < nt; t += 3) {
        NA_STEP(t, rkA, rvA, rkB, rvB);
        NA_STEP(t + 1, rkB, rvB, rkC, rvC);
        NA_STEP(t + 2, rkC, rvC, rkA, rvA);
    }
    lsum += __shfl_xor(lsum, 32);
    const float inv = 1.f / lsum;
    bf16* orow = O + qg * 2048 + h * 64;
#pragma unroll
    for (int g = 0; g < 4; ++g) {
        u32x2 w0, w1; w0.x = cvt_pk_bf16(o0[4 * g] * inv, o0[4 * g + 1] * inv); w0.y = cvt_pk_bf16(o0[4 * g + 2] * inv, o0[4 * g + 3] * inv);
        w1.x = cvt_pk_bf16(o1[4 * g] * inv, o1[4 * g + 1] * inv); w1.y = cvt_pk_bf16(o1[4 * g + 2] * inv, o1[4 * g + 3] * inv);
        *(u32x2*)(orow + 8 * g + 4 * hh) = w0; *(u32x2*)(orow + 32 + 8 * g + 4 * hh) = w1;
    }
#undef NA_ROW
#undef NA_LOAD
#undef NA_STORE
#undef NA_STEP
}
}

#define XB_TMO      128
#define XB_XCNT(j)  (256  + 64 * (j))
#define XB_XSUB(j)  (1280 + 64 * (j))
#define XB_XGEN(j)  (2304 + 64 * (j))
#define XB_TOP      3328
#define XB_TOPGEN   3392
#define XCD_BAR_WORDS 3456
#define XB_SPIN_CAP (1u << 22)
__device__ __forceinline__ unsigned xb_ld(unsigned* p)              { return __hip_atomic_load(p, __ATOMIC_RELAXED, __HIP_MEMORY_SCOPE_AGENT); }
__device__ __forceinline__ unsigned xb_add(unsigned* p, unsigned v) { return __hip_atomic_fetch_add(p, v, __ATOMIC_RELAXED, __HIP_MEMORY_SCOPE_AGENT); }
__device__ __forceinline__ unsigned xb_xcc_id() { return (unsigned)__builtin_amdgcn_s_getreg((3 << 11) | 20) & 0xFu; }
#define XB_SPIN(cond, bar) do { unsigned _sp = 0; while (cond) { __builtin_amdgcn_s_sleep(1); \
    if ((++_sp & 255u) == 0u) { if (xb_ld(&(bar)[XB_TMO])) break; if (_sp > XB_SPIN_CAP) { atomicAdd(&(bar)[XB_TMO], 1u); break; } } } } while (0)
struct XcdBarrier { unsigned* bar; unsigned x; volatile LAS unsigned* st; };
__device__ __forceinline__ XcdBarrier xcd_barrier_post(unsigned* bar, volatile LAS unsigned* st) {
    XcdBarrier b; b.bar = bar; b.x = xb_xcc_id(); b.st = st;
    if (threadIdx.x == 0) (void)xb_add(&bar[XB_XCNT(b.x)], 1u);
    return b;
}
__device__ __forceinline__ void xcd_barrier_complete(unsigned* bar, unsigned x, unsigned& nloc, unsigned& nx) {
    const unsigned G = gridDim.x * gridDim.y * gridDim.z;
    unsigned sum, cnt, mine, sp = 0u;
    for (;;) {
        sum = 0u; cnt = 0u; mine = 0u;
#pragma unroll
        for (unsigned j = 0; j < 16; ++j) { const unsigned c = xb_ld(&bar[XB_XCNT(j)]); sum += c; cnt += (c > 0u) ? 1u : 0u; mine = (j == x) ? c : mine; }
        if (sum == G) break;
        __builtin_amdgcn_s_sleep(1);
        if ((++sp & 255u) == 0u) { if (xb_ld(&bar[XB_TMO])) break; if (sp > XB_SPIN_CAP) { atomicAdd(&bar[XB_TMO], 1u); break; } }
    }
    nloc = mine > 0u ? mine : 1u; nx = cnt > 0u ? cnt : 1u;
}
__device__ __forceinline__ void xcd_barrier(const XcdBarrier& b) {
    asm volatile("s_waitcnt vmcnt(0)" ::: "memory");
    __syncthreads();
    if (threadIdx.x == 0) {
        unsigned* bar = b.bar;
        __builtin_amdgcn_s_waitcnt(0);
        unsigned nloc = b.st[0], nx = b.st[1];
        if (nloc == 0u) { xcd_barrier_complete(bar, b.x, nloc, nx); b.st[0] = nloc; b.st[1] = nx; }
        const unsigned old = xb_add(&bar[XB_XSUB(b.x)], 1u);
        const unsigned gen = old / nloc;
        if (old + 1u == (gen + 1u) * nloc) {
            __builtin_amdgcn_fence(__ATOMIC_RELEASE, "agent");
            asm volatile("s_waitcnt vmcnt(0)" ::: "memory");
            const unsigned og = xb_add(&bar[XB_TOP], 1u);
            const unsigned tg = og / nx;
            if (og + 1u == (tg + 1u) * nx) xb_add(&bar[XB_TOPGEN], 1u);
            else XB_SPIN(xb_ld(&bar[XB_TOPGEN]) == tg, bar);
            __builtin_amdgcn_fence(__ATOMIC_ACQUIRE, "agent");
            xb_add(&bar[XB_XGEN(b.x)], 1u);
            asm volatile("s_waitcnt vmcnt(0)" ::: "memory");
        } else {
            XB_SPIN(xb_ld(&bar[XB_XGEN(b.x)]) == gen, bar);
            __builtin_amdgcn_fence(__ATOMIC_ACQUIRE, "agent");
            asm volatile("s_waitcnt vmcnt(0)" ::: "memory");
        }
    }
    __syncthreads();
}

struct Args {
    const float *x, *c, *ctx, *c_ctx, *w_ada, *b_ada, *g_norm, *w_in, *na_rpb, *pool_w, *pool_scale, *mla_g_q, *mla_w_uq, *mla_g_kv, *mla_w_ukv, *conv_w, *w_branch, *w_out,
                *ffn_w1, *ffn_w3, *ffn_w2, *moe_router, *moe_w1, *moe_w3, *moe_w2;
    float* out; unsigned char* ws; int rep; int pad;
};
struct Frame { LAS unsigned char* lds; int tid, lane, wave, G, gw, NGW; };
#define CAS __attribute__((address_space(4)))
typedef const CAS Args* ArgP;
__device__ __forceinline__ ArgP kargs() { ArgP p = (ArgP)__builtin_amdgcn_kernarg_segment_ptr(); asm volatile("" : "+s"(p)); return p; }
__device__ __forceinline__ Frame make_frame() {
    extern __shared__ __attribute__((aligned(16))) unsigned char lds_raw[];
    Frame F; F.lds = (LAS unsigned char*)lds_raw; int t = threadIdx.x; asm volatile("" : "+v"(t)); F.tid = t; F.lane = t & 63; F.wave = __builtin_amdgcn_readfirstlane(t >> 6); F.G = gridDim.x;
    F.gw = blockIdx.x * 8 + F.wave; F.NGW = F.G * 8; return F;
}

__device__ __forceinline__ void xpose_item(const float* __restrict__ W, int ldw, int scol, const float* __restrict__ ksc, int k0, bf16* WT, int ldt, int drow, LAS float* scr, int lane) {
    if (scol >= 0) {
        float v[32];
#pragma unroll
        for (int i = 0; i < 32; ++i) { const int kk = 2 * i + (lane >> 5); v[i] = W[(size_t)(k0 + kk) * ldw + scol + (lane & 31)]; }
        if (ksc) {
#pragma unroll
            for (int i = 0; i < 32; ++i) { const int kk = 2 * i + (lane >> 5); v[i] *= ksc[k0 + kk]; } }
#pragma unroll
        for (int i = 0; i < 32; ++i) { const int kk = 2 * i + (lane >> 5); scr[kk * 33 + (lane & 31)] = v[i]; }
    } else {
#pragma unroll 8
        for (int i = 0; i < 32; ++i) { const int kk = 2 * i + (lane >> 5); scr[kk * 33 + (lane & 31)] = 0.f; }
    }
    LDS_WAIT(); asm volatile("" ::: "memory");
    const int c = lane & 7;
#pragma unroll
    for (int j = 0; j < 4; ++j) { const int n = (lane >> 3) + 8 * j; const LAS float* s = scr + (8 * c) * 33 + n;
        u32x4 o; o.x = pk2(s[0 * 33], s[1 * 33]); o.y = pk2(s[2 * 33], s[3 * 33]); o.z = pk2(s[4 * 33], s[5 * 33]); o.w = pk2(s[6 * 33], s[7 * 33]);
        *(u32x4*)(WT + (size_t)(drow + n) * ldt + k0 + 8 * c) = o; }
    LDS_WAIT(); asm volatile("" ::: "memory");
}
__device__ __forceinline__ void xpose_item_f8(const float* __restrict__ W, int ldw, int scol, float scale, int k0, unsigned char* WT, int ldt, int drow, LAS float* scr, int lane) {
    float v[32];
#pragma unroll
    for (int i = 0; i < 32; ++i) { const int kk = 2 * i + (lane >> 5); v[i] = W[(size_t)(k0 + kk) * ldw + scol + (lane & 31)]; }
#pragma unroll
    for (int i = 0; i < 32; ++i) { const int kk = 2 * i + (lane >> 5); scr[kk * 33 + (lane & 31)] = v[i] * scale; }
    LDS_WAIT(); asm volatile("" ::: "memory");
    const int c = lane & 7;
#pragma unroll
    for (int j = 0; j < 4; ++j) { const int n = (lane >> 3) + 8 * j; const LAS float* q = scr + (8 * c) * 33 + n;
        u32x2 o; o.x = pk4_fp8(q[0 * 33], q[1 * 33], q[2 * 33], q[3 * 33]); o.y = pk4_fp8(q[4 * 33], q[5 * 33], q[6 * 33], q[7 * 33]);
        *(u32x2*)(WT + (size_t)(drow + n) * ldt + k0 + 8 * c) = o; }
    LDS_WAIT(); asm volatile("" ::: "memory");
}
__device__ __forceinline__ int win_src_col(int n) { return n < 2048 ? n : (n < 7680 ? n + 672 : (n < 8352 ? n - 7680 + 2048 : -1)); }

__device__ __forceinline__ void phase_prologue() {
    ArgP a = kargs(); Frame F = make_frame();
    unsigned char* ws = a->ws;
    LAS float* scr = (LAS float*)(F.lds + F.wave * 16384);
    constexpr int I_WIN = 16 * (NPROJ / 32), I_WUQ = 6 * 24, I_WUKV = 4 * 32, I_WBR = 4 * 8 * 32, I_WOUT = 16 * 32, I_L = I_WIN + I_WUQ + I_WUKV + I_WBR + I_WOUT;
    constexpr int I_F13 = 16 * (2 * DFF / 32), I_F2 = (DFF / 64) * 32, NITEMS = 2 * I_L + I_F13 + I_F2;
    for (int it = F.gw; it < NITEMS; it += F.NGW) {
        int r = it;
        if (r < 2 * I_L) { const int l = r / I_L; r -= l * I_L; unsigned char* wl = ws + WS_WOTHER + l * WL_SIZE;
            if (r < I_WIN) { const int nb = r % (NPROJ / 32), kb = r / (NPROJ / 32);
                if (nb >= C_GATE / 32 && nb < (C_GATE + 4096) / 32)
                    xpose_item_f8(a->w_in + (size_t)l * 1024 * NREF, NREF, win_src_col(nb * 32), W13_SCALE, kb * 64, wl + WL_WIN + (size_t)C_GATE * 1024 * 2, 1024, nb * 32 - C_GATE, scr, F.lane);
                else xpose_item(a->w_in + (size_t)l * 1024 * NREF, NREF, win_src_col(nb * 32), nullptr, kb * 64, (bf16*)(wl + WL_WIN), 1024, nb * 32, scr, F.lane);
                continue; } r -= I_WIN;
            if (r < I_WUQ) { const int nb = r % 24, kb = r / 24; xpose_item(a->mla_w_uq + (size_t)l * 384 * 768, 768, nb * 32, a->mla_g_q + l * 384, kb * 64, (bf16*)(wl + WL_WUQ), 384, nb * 32, scr, F.lane); continue; } r -= I_WUQ;
            if (r < I_WUKV) { const int nb = r % 32, kb = r / 32; xpose_item(a->mla_w_ukv + (size_t)l * 256 * 1024, 1024, nb * 32, a->mla_g_kv + l * 256, kb * 64, (bf16*)(wl + WL_WUKV), 256, nb * 32, scr, F.lane); continue; } r -= I_WUKV;
            if (r < I_WBR) { const int k = r / 256, rr = r % 256, nb = rr % 32, kb = rr / 32; xpose_item(a->w_branch + ((size_t)l * 4 + k) * 512 * 1024, 1024, nb * 32, nullptr, kb * 64, (k == 1) ? (bf16*)(ws + WS_E) + (size_t)l * 1024 * 512 : (bf16*)(wl + WL_WBR) + k * 512, (k == 1) ? 512 : 2048, nb * 32, scr, F.lane); continue; } r -= I_WBR;
            { const int nb = r % 32, kb = r / 32; xpose_item(a->w_out + (size_t)l * 1024 * 1024, 1024, nb * 32, nullptr, kb * 64, (bf16*)(wl + WL_WOUT), 1024, nb * 32, scr, F.lane); continue; }
        }
        r -= 2 * I_L;
        if (r < I_F13) { const int nb = r % (2 * DFF / 32), kb = r / (2 * DFF / 32); const int n0 = nb * 32, tile = n0 >> 8, w = n0 & 255;
            const float* src = (w < 128) ? a->ffn_w1 : a->ffn_w3; xpose_item(src, DFF, tile * 128 + (w & 127), nullptr, kb * 64, (bf16*)(ws + WS_WOTHER + WO_F13), 1024, n0, scr, F.lane); continue; }
        r -= I_F13;
        { const int nb = r % 32, kb = r / 32; xpose_item(a->ffn_w2, 1024, nb * 32, nullptr, kb * 64, (bf16*)(ws + WS_WOTHER + WO_F2), DFF, nb * 32, scr, F.lane); }
    }
    { const float* pw = a->pool_w; const float* psc = a->pool_scale;
      for (int idx = F.gw * 64 + F.lane; idx < 2 * 512 * 512; idx += F.NGW * 64) { const int l = idx >> 18, c = (idx >> 9) & 511, j = idx & 511, g = c >> 7;
        const float v = ((j >> 7) == g) ? pw[(((size_t)l * 4 + g) * 128 + (c & 127)) * 128 + (j & 127)] * psc[l * 512 + j] : 0.f;
        ((bf16*)(ws + WS_WOTHER + l * WL_SIZE + WL_WPOOL))[c * 512 + j] = (bf16)f2bf(v); } }
    if (blockIdx.x == 0) { float* ct = (float*)(ws + WS_ROPE); float* st = ct + 1024;
        for (int i = F.tid; i < 1024; i += 512) { const int p = i >> 3, j = i & 7; const float inv = powf(10000.f, -(float)j / 8.f); const float ang = (float)p * inv; ct[i] = (float)cos((double)ang); st[i] = (float)sin((double)ang); } }
    __syncthreads();
    {
        LAS float* sc = (LAS float*)F.lds;
        LAS float* red = sc + 3 * 1024;
        const float* cc = a->c; const float* cx = a->c_ctx; const float* wada = a->w_ada; const float* bada = a->b_ada;
        for (int i = F.tid; i < 3 * 1024; i += 512) { const int v = i >> 10, k = i & 1023; const float cvv = (v < 2) ? cc[v * 1024 + k] : cx[k]; sc[i] = cvv / (1.f + expf(-cvv)); }
        __syncthreads();
        for (int cb = blockIdx.x; cb < 2 * 6144 / 64; cb += F.G) { const int l = cb / 96, n = (cb % 96) * 64 + (F.tid & 63), kg = F.tid >> 6;
            const float* w = wada + ((size_t)l * 1024 + kg * 128) * 6144 + n; float a0 = 0.f, a1 = 0.f, a2 = 0.f;
            for (int kb = 0; kb < 128; kb += 32) { float wv[32];
#pragma unroll
                for (int k = 0; k < 32; ++k) wv[k] = w[(size_t)(kb + k) * 6144];
#pragma unroll
                for (int k = 0; k < 32; ++k) { a0 += sc[kg * 128 + kb + k] * wv[k]; a1 += sc[1024 + kg * 128 + kb + k] * wv[k]; a2 += sc[2048 + kg * 128 + kb + k] * wv[k]; } }
            red[(kg * 3 + 0) * 64 + (F.tid & 63)] = a0; red[(kg * 3 + 1) * 64 + (F.tid & 63)] = a1; red[(kg * 3 + 2) * 64 + (F.tid & 63)] = a2;
            __syncthreads();
            if (F.tid < 192) { const int v = F.tid >> 6, j = F.tid & 63; float s = bada[l * 6144 + (cb % 96) * 64 + j];
#pragma unroll
                for (int g = 0; g < 8; ++g) s += red[(g * 3 + v) * 64 + j];
                ((float*)(ws + WS_MOD))[((size_t)l * 3 + v) * 6144 + (cb % 96) * 64 + j] = s; }
            __syncthreads();
        }
    }
}

__device__ __forceinline__ void moe_convert() {
    ArgP a = kargs(); Frame F = make_frame(); unsigned char* ws = a->ws;
    const float* w1 = a->moe_w1; const float* w3 = a->moe_w3; const float* w2 = a->moe_w2;
    LAS float* scr = (LAS float*)(F.lds + 32768 + F.wave * 8704);
    constexpr int I13 = 16 * (2 * DFE / 32), I2 = (DFE / 64) * 32, IE = I13 + I2;
    for (int it = F.gw; it < NEXP * IE; it += F.NGW) { const int e = it / IE; int r = it % IE;
        if (r < I13) { const int nb = r % (2 * DFE / 32), kb = r / (2 * DFE / 32); const int n0 = nb * 32, tile = n0 >> 8, w = n0 & 255;
            const float* src = ((w < 128) ? w1 : w3) + (size_t)e * 1024 * DFE;
            xpose_item_f8(src, DFE, tile * 128 + (w & 127), W13_SCALE, kb * 64, ws + WS_WMOE13 + (size_t)e * 7168 * 1024, 1024, n0, scr, F.lane); }
        else { r -= I13; const int nb = r % 32, kb = r / 32; xpose_item_f8(w2 + (size_t)e * DFE * 1024, 1024, nb * 32, W2_SCALE, kb * 64, ws + WS_WMOE2 + (size_t)e * 1024 * DFE, DFE, nb * 32, scr, F.lane); }
    }
}

__device__ __forceinline__ const float* modp(const unsigned char* ws, int l, int row, int j) { const int v = row < TL ? (row >> 13) : 2; return (const float*)(ws + WS_MOD) + (((size_t)l * 3 + v) * 6 + j) * 1024; }

__device__ __forceinline__ void moe_panel_starts(const unsigned char* ws, int (&pst)[NEXP], int& npan) {
    unsigned* cnt = (unsigned*)(ws + WS_CTL) + CW_CNT; int acc = 0;
#pragma unroll
    for (int e = 0; e < NEXP; ++e) { pst[e] = acc; acc += (int)((__hip_atomic_load(cnt + e * 64, RLX_AGENT) + 255u) >> 8); }
    npan = acc < MAXPAN ? acc : MAXPAN;
}
struct ColVec { f32x4 v[4]; };
__device__ __forceinline__ void colvec_load(ColVec& c, const float* p, int lane) {
#pragma unroll
    for (int j = 0; j < 4; ++j) c.v[j] = *(const f32x4*)(p + 4 * lane + 256 * j);
}
template <bool F8COPY = false>
__device__ __forceinline__ void norm_mod_store(const f32x4 (&xv)[4], const ColVec& g, const ColVec& shift, const ColVec& scale, bf16* orow, int lane, f32x4 (&tv)[4], unsigned char* o8row = nullptr) {
    float ss = 0.f;
#pragma unroll
    for (int j = 0; j < 4; ++j) ss += (xv[j].x * xv[j].x + xv[j].y * xv[j].y) + (xv[j].z * xv[j].z + xv[j].w * xv[j].w);
    const float r = rsqrtf(wave_sum(ss) * (1.f / 1024.f) + EPS);
#pragma unroll
    for (int j = 0; j < 4; ++j) { const int c = 4 * lane + 256 * j; const f32x4 gg = g.v[j], sh = shift.v[j], scl = scale.v[j];
        f32x4 t; t.x = (xv[j].x * r * gg.x) * (1.f + scl.x) + sh.x; t.y = (xv[j].y * r * gg.y) * (1.f + scl.y) + sh.y; t.z = (xv[j].z * r * gg.z) * (1.f + scl.z) + sh.z; t.w = (xv[j].w * r * gg.w) * (1.f + scl.w) + sh.w; tv[j] = t;
        u32x2 o; o.x = pk2(t.x, t.y); o.y = pk2(t.z, t.w); *(u32x2*)(orow + c) = o;
        if (F8COPY) *(unsigned*)(o8row + c) = pk4_fp8(t.x, t.y, t.z, t.w); }
}

struct SchedOne {
    int pm, pn; const char* A; const char* B; size_t tA, tB;
    __device__ __forceinline__ bool next(int i, Unit& u) const { u.pm = pm; u.pn = pn; u.aux = 0; return i == 0; }
    __device__ __forceinline__ void bases(const Unit& u, const char*& a, const char*& b) const { a = A + (size_t)u.pm * tA; b = B + (size_t)u.pn * tB; }
};
__device__ __forceinline__ void phase_norm_in() {
    ArgP a = kargs(); Frame F = make_frame(); unsigned char* ws = a->ws; const float* gn = a->g_norm; const float* xin = a->x; const float* cin = a->ctx;
    bf16* H = (bf16*)(ws + WS_C);
    const int nW = F.G >= 64 ? 16 : 0;
    for (int u = blockIdx.x; u < 16; u += (nW ? 16 : F.G)) { if (nW && (int)blockIdx.x >= 16) break;
        const int l = u >> 3, pm = (u >> 1) & 3, pn = u & 1; unsigned char* wl = ws + WS_WOTHER + (size_t)l * WL_SIZE;
        SchedOne S{pm, pn, (const char*)(ws + WS_E) + (size_t)l * 1024 * 512 * 2, (const char*)(wl + WL_WPOOL), (size_t)256 * 512 * 2, (size_t)256 * 512 * 2};
        EpiRowScale E{(bf16*)(wl + WL_WBR) + 512, 2048, nullptr, 0, 1.f};
        pg8::gemm_phase(F.lds, pg8::Gemm{512, 512, 512}, S, E); }
    if (nW && (int)blockIdx.x < 16) return;
    const int gw = nW ? ((int)blockIdx.x - 16) * 8 + F.wave : F.gw, ngw = nW ? (F.G - 16) * 8 : F.NGW;
    ColVec pg, psh, psc; colvec_load(pg, gn, F.lane); int curv = -1;
    for (int row = gw; row < T; row += ngw) { const float* xr = row < TL ? xin + (size_t)row * 1024 : cin + (size_t)(row - TL) * 1024;
        const int v = row < TL ? (row >> 13) : 2; if (v != curv) { colvec_load(psh, modp(ws, 0, row, 0), F.lane); colvec_load(psc, modp(ws, 0, row, 1), F.lane); curv = v; }
        f32x4 xv[4], tv[4];
#pragma unroll
        for (int j = 0; j < 4; ++j) xv[j] = *(const f32x4*)(xr + 4 * F.lane + 256 * j);
        norm_mod_store<true>(xv, pg, psh, psc, H + (size_t)row * 1024, F.lane, tv, ws + WS_H8 + (size_t)row * 1024); }
}

template <bool MOE, bool ROUTE, bool SRCIN, bool HAS2, bool F8OUT = false>
__device__ __forceinline__ void phase_resid(int nrows, size_t y_off, int l, int jgate, int ga_idx, int gb_idx, int lb, int jshift, size_t out_off) {
    ArgP a = kargs(); Frame F = make_frame(); unsigned char* ws = a->ws;
    const bf16* Y = (const bf16*)(ws + y_off); bf16* OUT = (bf16*)(ws + out_off);
    const float* gnorm = a->g_norm; const float* ga = gnorm + ga_idx * 1024; const float* gb = gnorm + gb_idx * 1024;
    float* xdst_lat = a->out; float* xdst_ctx = (float*)(ws + WS_XC);
    const float* xsrc_lat = SRCIN ? a->x : (const float*)xdst_lat; const float* xsrc_ctx = SRCIN ? a->ctx : (const float*)xdst_ctx;
    int moe_lim = 0; if (MOE) { int pst_[NEXP], npan_; moe_panel_starts(ws, pst_, npan_); moe_lim = (npan_ < 128 ? npan_ : 128) * 256; }
    const LAS float* rt = (const LAS float*)F.lds;
    if (ROUTE) { const float* mr = a->moe_router; for (int i = F.tid; i < 8192; i += 512) ((LAS float*)F.lds)[i] = mr[i]; __syncthreads(); }
    ColVec pga, pgb, pgt, psh, psc; colvec_load(pga, ga, F.lane); if (HAS2) colvec_load(pgb, gb, F.lane); int curv = -1;
    constexpr int NR = ROUTE ? 1 : 2;
    const int it_n = ROUTE ? ((nrows / 64 - (int)blockIdx.x + F.G - 1) / F.G) * 8 : 0; unsigned cntw = 0u;
    for (int rowb = ROUTE ? 0 : F.gw, it = 0; ROUTE ? (it < it_n) : (rowb < nrows); rowb += NR * F.NGW, ++it) {
        if (ROUTE) rowb = ((int)blockIdx.x + (it >> 3) * F.G) * 64 + F.wave * 8 + (it & 7);
        f32x4 yv[NR][4], xv[NR][4], tv[NR][4]; bool ok[NR]; int rows[NR];
#pragma unroll
        for (int q = 0; q < NR; ++q) { const int row = rowb + q * F.NGW; rows[q] = row; ok[q] = row < nrows;
            if (ok[q]) { const float* xr = row < TL ? xsrc_lat + (size_t)row * 1024 : xsrc_ctx + (size_t)(row - TL) * 1024;
                if (MOE) { const int* t2s = (const int*)(ws + WS_TOK2SLOT) + row * 2;
#pragma unroll
                    for (int j = 0; j < 4; ++j) yv[q][j] = (f32x4){0.f, 0.f, 0.f, 0.f};
#pragma unroll
                    for (int k = 0; k < 2; ++k) { const int sl = t2s[k];
                        if (sl < moe_lim) {
#pragma unroll
                            for (int j = 0; j < 4; ++j) { const u32x2 u0 = *(const u32x2*)(Y + (size_t)sl * 1024 + 4 * F.lane + 256 * j); yv[q][j] += (f32x4){bflo(u0.x), bfhi(u0.x), bflo(u0.y), bfhi(u0.y)}; }
                        } else { const float* sp = (const float*)(ws + WS_D) + (size_t)(sl - moe_lim) * 1024 + 4 * F.lane;
#pragma unroll
                            for (int ks = 0; ks < 2; ++ks)
#pragma unroll
                                for (int j = 0; j < 4; ++j) yv[q][j] += *(const f32x4*)(sp + (size_t)ks * (8 * 256 * 1024) + 256 * j); } }
                } else {
#pragma unroll
                    for (int j = 0; j < 4; ++j) { const u32x2 u0 = *(const u32x2*)(Y + (size_t)row * 1024 + 4 * F.lane + 256 * j); yv[q][j] = (f32x4){bflo(u0.x), bfhi(u0.x), bflo(u0.y), bfhi(u0.y)}; }
                }
#pragma unroll
                for (int j = 0; j < 4; ++j) xv[q][j] = *(const f32x4*)(xr + 4 * F.lane + 256 * j); } }
#pragma unroll
        for (int q = 0; q < NR; ++q) if (ok[q]) { const int row = rows[q];
            float* xw = row < TL ? xdst_lat + (size_t)row * 1024 : xdst_ctx + (size_t)(row - TL) * 1024;
            float ss = 0.f;
#pragma unroll
            for (int j = 0; j < 4; ++j) ss += (yv[q][j].x * yv[q][j].x + yv[q][j].y * yv[q][j].y) + (yv[q][j].z * yv[q][j].z + yv[q][j].w * yv[q][j].w);
            const float r = rsqrtf(wave_sum(ss) * (1.f / 1024.f) + EPS);
            { const int v = row < TL ? (row >> 13) : 2; if (v != curv) { colvec_load(pgt, modp(ws, l, row, jgate), F.lane); if (HAS2) { colvec_load(psh, modp(ws, lb, row, jshift), F.lane); colvec_load(psc, modp(ws, lb, row, jshift + 1), F.lane); } curv = v; } }
#pragma unroll
            for (int j = 0; j < 4; ++j) { const int c = 4 * F.lane + 256 * j; const f32x4 gg = pga.v[j], gv = pgt.v[j];
                xv[q][j].x += gv.x * (yv[q][j].x * r * gg.x); xv[q][j].y += gv.y * (yv[q][j].y * r * gg.y); xv[q][j].z += gv.z * (yv[q][j].z * r * gg.z); xv[q][j].w += gv.w * (yv[q][j].w * r * gg.w);
                *(f32x4*)(xw + c) = xv[q][j]; }
            if (HAS2) {
                norm_mod_store<F8OUT>(xv[q], pgb, psh, psc, OUT + (size_t)row * 1024, F.lane, tv[q], ws + WS_H8 + (size_t)row * 1024);
                if (ROUTE) {
                    float lg[8];
#pragma unroll
                    for (int e = 0; e < 8; ++e) lg[e] = 0.f;
#pragma unroll
                    for (int j = 0; j < 4; ++j)
#pragma unroll
                        for (int i = 0; i < 4; ++i) { const int c = 4 * F.lane + 256 * j + i; const f32x4 r0 = *(const LAS f32x4*)(rt + c * 8), r1 = *(const LAS f32x4*)(rt + c * 8 + 4); const float tvv = tv[q][j][i];
                            lg[0] += tvv * r0.x; lg[1] += tvv * r0.y; lg[2] += tvv * r0.z; lg[3] += tvv * r0.w; lg[4] += tvv * r1.x; lg[5] += tvv * r1.y; lg[6] += tvv * r1.z; lg[7] += tvv * r1.w; }
#pragma unroll
                    for (int e = 0; e < 8; ++e) lg[e] = wave_sum(lg[e]);
                    int e0 = 0; float v0 = lg[0];
#pragma unroll
                    for (int e = 1; e < 8; ++e) if (lg[e] > v0) { v0 = lg[e]; e0 = e; }
                    int e1 = -1; float v1 = -INFINITY;
#pragma unroll
                    for (int e = 0; e < 8; ++e) if (e != e0 && lg[e] > v1) { v1 = lg[e]; e1 = e; }
                    cntw += (1u << (4 * e0)) + (1u << (4 * e1));
                    if (F.lane == 0) { const float w0 = 1.f / (1.f + expf(v1 - v0)), w1 = 1.f - w0;
                        int* ro = (int*)(ws + WS_ROUTE) + (size_t)row * 8; ro[0] = e0; ro[1] = e1; ((float*)ro)[4] = w0; ((float*)ro)[5] = w1; }
                }
            }
        }
        if (ROUTE && (it & 7) == 7) {
            LAS unsigned* wc = (LAS unsigned*)(F.lds + 32768);
            if (F.lane == 0) wc[F.wave] = cntw;
            cntw = 0u; __syncthreads();
            if (F.tid < NEXP) { unsigned sum = 0u;
#pragma unroll
                for (int w = 0; w < 8; ++w) sum += (wc[w] >> (4 * F.tid)) & 15u;
                const int blk = (int)blockIdx.x + (it >> 3) * F.G;
                ((int*)(ws + WS_BLKCNT))[blk * 8 + F.tid] = (int)sum; atomicAdd((unsigned*)(ws + WS_CTL) + CW_CNT + F.tid * 64, sum); }
            __syncthreads();
        }
    }
}

__device__ __forceinline__ void phase_prep(int l) {
    ArgP a = kargs(); Frame F = make_frame(); unsigned char* ws = a->ws;
    const bf16* P = (const bf16*)(ws + WS_PROJ); bf16* O = (bf16*)(ws + WS_O); float* RS = (float*)(ws + WS_RS); bf16* KR = (bf16*)(ws + WS_KR);
    const float* ct = (const float*)(ws + WS_ROPE); const float* st = ct + 1024; const float* cw = a->conv_w + l * 3 * 512; const int lane = F.lane;
    const int l48 = lane < 48 ? lane : 47, l32 = lane & 31, l16 = lane & 15, pw = 2 << (lane >> 4);
#define PREP_SEQ(row, latent, base, t, N) const bool latent = row < TL; int base, t, N; \
        if (latent) { base = row & ~(SEQ - 1); t = row & (SEQ - 1); N = SEQ; } else { const int rr_ = row - TL; base = TL + (rr_ & ~(CTXL - 1)); t = rr_ & (CTXL - 1); N = CTXL; }
    {   f32x4 cw0[3], cw1[3];
#pragma unroll
        for (int j = 0; j < 3; ++j) { cw0[j] = *(const f32x4*)(cw + j * 512 + 8 * lane); cw1[j] = *(const f32x4*)(cw + j * 512 + 8 * lane + 4); }
        struct RowA { u32x4 vq, vk, bg, cg[3], xc[3]; unsigned vr; float rc, rsn; };
        for (int rowb = F.gw; rowb < T; rowb += 2 * F.NGW) { RowA R[2];
#pragma unroll
            for (int q = 0; q < 2; ++q) { int row = rowb + q * F.NGW; row = row < T ? row : T - 1; PREP_SEQ(row, latent, base, t, N) (void)latent;
                const bf16* pr = P + (size_t)row * NPROJ; RowA& r = R[q];
                r.vq = *(const u32x4*)(pr + C_CQ + 8 * l48); r.vk = *(const u32x4*)(pr + C_CKV + 8 * l32); r.vr = *(const unsigned*)(pr + C_KR + 2 * l16); r.bg = *(const u32x4*)(pr + C_BG + 8 * lane);
                const int pos = (l16 < 8) ? (t >> 6) : (t & 63); r.rc = ct[pos * 8 + (l16 & 7)]; r.rsn = st[pos * 8 + (l16 & 7)];
#pragma unroll
                for (int j = 0; j < 3; ++j) { int rr = t + j - 1; rr = rr < 0 ? 0 : (rr < N ? rr : N - 1); const bf16* qp = P + (size_t)(base + rr) * NPROJ; r.cg[j] = *(const u32x4*)(qp + C_CG + 8 * lane); r.xc[j] = *(const u32x4*)(qp + C_XC + 8 * lane); } }
#pragma unroll
            for (int q = 0; q < 2; ++q) { int row = rowb + q * F.NGW; row = row < T ? row : T - 1; PREP_SEQ(row, latent, base, t, N) (void)base; const RowA& r = R[q];
                float sq = 0.f, sk = 0.f;
                { const float f[8] = {bflo(r.vq.x), bfhi(r.vq.x), bflo(r.vq.y), bfhi(r.vq.y), bflo(r.vq.z), bfhi(r.vq.z), bflo(r.vq.w), bfhi(r.vq.w)};
#pragma unroll
                  for (int i = 0; i < 8; ++i) sq += f[i] * f[i];
                  sq = lane < 48 ? sq : 0.f; }
                { const float f[8] = {bflo(r.vk.x), bfhi(r.vk.x), bflo(r.vk.y), bfhi(r.vk.y), bflo(r.vk.z), bfhi(r.vk.z), bflo(r.vk.w), bfhi(r.vk.w)};
#pragma unroll
                  for (int i = 0; i < 8; ++i) sk += f[i] * f[i];
                  sk = lane < 32 ? sk : 0.f; }
                sq = wave_sum(sq); sk = wave_sum(sk);
                if (lane == 0) { RS[(size_t)row * 2] = rsqrtf(sq * (1.f / 384.f) + EPS); RS[(size_t)row * 2 + 1] = rsqrtf(sk * (1.f / 256.f) + EPS); }
                if (lane < 16) { float x0 = bflo(r.vr), x1 = bfhi(r.vr);
                    if (latent) { const float y0 = x0 * r.rc - x1 * r.rsn, y1 = x0 * r.rsn + x1 * r.rc; x0 = y0; x1 = y1; }
                    *(unsigned*)(KR + (size_t)row * 32 + 2 * lane) = pk2(x0, x1); }
                float acc[8];
#pragma unroll
                for (int i = 0; i < 8; ++i) acc[i] = 0.f;
#pragma unroll
                for (int j = 0; j < 3; ++j) { const int rr = t + j - 1; const float mk = (rr >= 0 && rr < N) ? 1.f : 0.f; const f32x4 w0 = cw0[j] * mk, w1 = cw1[j] * mk; const u32x4 c = r.cg[j], x = r.xc[j];
                    acc[0] += w0.x * bflo(c.x) * bflo(x.x); acc[1] += w0.y * bfhi(c.x) * bfhi(x.x); acc[2] += w0.z * bflo(c.y) * bflo(x.y); acc[3] += w0.w * bfhi(c.y) * bfhi(x.y);
                    acc[4] += w1.x * bflo(c.z) * bflo(x.z); acc[5] += w1.y * bfhi(c.z) * bfhi(x.z); acc[6] += w1.z * bflo(c.w) * bflo(x.w); acc[7] += w1.w * bfhi(c.w) * bfhi(x.w); }
                const u32x4 bg = r.bg;
                u32x4 o; o.x = pk2(acc[0] * bflo(bg.x), acc[1] * bfhi(bg.x)); o.y = pk2(acc[2] * bflo(bg.y), acc[3] * bfhi(bg.y)); o.z = pk2(acc[4] * bflo(bg.z), acc[5] * bfhi(bg.z)); o.w = pk2(acc[6] * bflo(bg.w), acc[7] * bfhi(bg.w));
                *(u32x4*)(O + (size_t)row * 2048 + 1536 + 8 * lane) = o; }
        }
    }
    {
        static_assert(T % 3 == 0, "row triples");
        for (int blk = F.gw; blk < T / 3; blk += F.NGW) { const int r0 = 3 * blk; u32x4 pv[19];
#pragma unroll
            for (int i = 0; i < 19; ++i) { int g = r0 - 8 + i; g = g < 0 ? 0 : (g < T ? g : T - 1); pv[i] = *(const u32x4*)(P + (size_t)g * NPROJ + C_UP + 8 * lane); }
#pragma unroll
            for (int q = 0; q < 3; ++q) { const int row = r0 + q; PREP_SEQ(row, latent, base, t, N) (void)latent;
                int lo = t - (pw >> 1), hi = lo + pw; lo = lo < 0 ? 0 : lo; hi = hi > N ? N : hi; const int glo = base + lo, ghi = base + hi;
                float acc[8];
#pragma unroll
                for (int i = 0; i < 8; ++i) acc[i] = 0.f;
#pragma unroll
                for (int i = 0; i < 19; ++i) { const int g = r0 - 8 + i; const u32x4 v = pv[i]; const float mk = (g >= glo && g < ghi) ? 1.f : 0.f;
                    acc[0] += mk * bflo(v.x); acc[1] += mk * bfhi(v.x); acc[2] += mk * bflo(v.y); acc[3] += mk * bfhi(v.y); acc[4] += mk * bflo(v.z); acc[5] += mk * bfhi(v.z); acc[6] += mk * bflo(v.w); acc[7] += mk * bfhi(v.w); }
                const float ic = 1.f / (float)(hi - lo); const u32x4 s_ = pv[8 + q];
                u32x4 o; o.x = pk2(acc[0] * ic - bflo(s_.x), acc[1] * ic - bfhi(s_.x)); o.y = pk2(acc[2] * ic - bflo(s_.y), acc[3] * ic - bfhi(s_.y));
                o.z = pk2(acc[4] * ic - bflo(s_.z), acc[5] * ic - bfhi(s_.z)); o.w = pk2(acc[6] * ic - bflo(s_.w), acc[7] * ic - bfhi(s_.w));
                *(u32x4*)(O + (size_t)row * 2048 + 512 + 8 * lane) = o; }
        }
    }
#undef PREP_SEQ
}

__device__ __forceinline__ void phase_moe_gather() {
    ArgP a = kargs(); Frame F = make_frame(); unsigned char* ws = a->ws;
    int pst[NEXP], npan; moe_panel_starts(ws, pst, npan);
    const bf16* TI = (const bf16*)(ws + WS_C); unsigned char* TP = ws + WS_E;   float* SW = (float*)(ws + WS_SLOTW); int* T2S = (int*)(ws + WS_TOK2SLOT); const int* BLK = (const int*)(ws + WS_BLKCNT);
    LAS int* pre = (LAS int*)F.lds;
    LAS int* slots = pre + 16;
    for (int blk = blockIdx.x; blk < TL / 64; blk += F.G) {
        u32x4 rv0[8], rv1[8];
#pragma unroll
        for (int i = 0; i < 8; ++i) { const int row = blk * 64 + F.wave * 8 + i; rv0[i] = *(const u32x4*)(TI + (size_t)row * 1024 + 8 * F.lane); rv1[i] = *(const u32x4*)(TI + (size_t)row * 1024 + 512 + 8 * F.lane); }
        if (F.tid < 16) pre[F.tid] = 0;
        __syncthreads();
        for (int idx = F.tid; idx < blk * 8; idx += 512) __hip_atomic_fetch_add(&pre[idx & 7], BLK[idx], __ATOMIC_RELAXED, __HIP_MEMORY_SCOPE_WORKGROUP);
        __syncthreads();
        if (F.wave == 0) { const int row = blk * 64 + F.lane; const int* ro = (const int*)(ws + WS_ROUTE) + (size_t)row * 8; const int e0 = ro[0], e1 = ro[1];
            const unsigned long long lt = (1ull << F.lane) - 1ull; int s0 = 0, s1 = 0;
#pragma unroll
            for (int e = 0; e < NEXP; ++e) { const unsigned long long m = __ballot(e0 == e) | __ballot(e1 == e); const int base = pst[e] * 256 + pre[e] + __popcll(m & lt);
                s0 = (e0 == e) ? base : s0; s1 = (e1 == e) ? base : s1; }
            slots[2 * F.lane] = s0; slots[2 * F.lane + 1] = s1;
            T2S[row * 2] = s0; T2S[row * 2 + 1] = s1; SW[s0] = ((const float*)ro)[4]; SW[s1] = ((const float*)ro)[5]; }
        __syncthreads();
#pragma unroll
        for (int i = 0; i < 8; ++i) { const int tl = F.wave * 8 + i; const u32x4 a0 = rv0[i], a1 = rv1[i]; u32x2 f0, f1;
            f0.x = pk4_fp8(bflo(a0.x), bfhi(a0.x), bflo(a0.y), bfhi(a0.y)); f0.y = pk4_fp8(bflo(a0.z), bfhi(a0.z), bflo(a0.w), bfhi(a0.w));
            f1.x = pk4_fp8(bflo(a1.x), bfhi(a1.x), bflo(a1.y), bfhi(a1.y)); f1.y = pk4_fp8(bflo(a1.z), bfhi(a1.z), bflo(a1.w), bfhi(a1.w));
#pragma unroll
            for (int k = 0; k < 2; ++k) { const int slot = slots[2 * tl + k];
                *(u32x2*)(TP + (size_t)slot * 1024 + 8 * F.lane) = f0; *(u32x2*)(TP + (size_t)slot * 1024 + 512 + 8 * F.lane) = f1; } }
        __syncthreads();
    }
}

__device__ __forceinline__ void phase_attention(int l, bool with_ctx, int part) {
    ArgP a = kargs(); Frame F = make_frame(); unsigned char* ws = a->ws;
    const bf16* P = (const bf16*)(ws + WS_PROJ); const bf16* QM = (const bf16*)(ws + WS_D); const bf16* KV = (const bf16*)(ws + WS_C); const bf16* KR = (const bf16*)(ws + WS_KR); bf16* O = (bf16*)(ws + WS_O);
    const int wid = F.wave, bx = blockIdx.x; const float* ctab = (const float*)(ws + WS_ROPE);
    if (part & 1) {
    for (int u = bx; u < 512; u += F.G) { const int bh = (u & 7) + 8 * (u >> 8), qb = (u >> 3) & 31, b = bh >> 3, h = bh & 7; const int qrow0 = b * SEQ + qb * 256 + wid * 32;
        att::attn_unit<96, false, true>(F.lds, QM + (size_t)qrow0 * 768 + h * 96, 768, KV + h * 128, 1024, KV + h * 128 + 64, 1024, KR, O + (size_t)qrow0 * 2048 + 1024 + h * 64, 2048, 128, b * SEQ, TL + b * CTXL, 132, 0, 0, 0, qb * 256 + wid * 32, ctab); }
    if (with_ctx) for (int u = bx; u < 16; u += F.G) { const int b = u >> 3, h = u & 7; const int qrow0 = TL + b * CTXL + wid * 32;
        att::attn_unit<96, false, false>(F.lds, QM + (size_t)qrow0 * 768 + h * 96, 768, KV + h * 128, 1024, KV + h * 128 + 64, 1024, KR, O + (size_t)qrow0 * 2048 + 1024 + h * 64, 2048, 0, 0, TL + b * CTXL, 4, 0, 0, 0, 0, ctab); }
    }
#ifdef ATT_DBG
    if (part & 4) { bf16* OD = (bf16*)(ws + WS_E);
    for (int u = bx; u < 512; u += F.G) { const int bh = (u & 7) + 8 * (u >> 8), qb = (u >> 3) & 31, b = bh >> 3, h = bh & 7; const int qrow0 = b * SEQ + qb * 256 + wid * 32;
        att::attn_unit<96, false, true, ATT_DBG>(F.lds, QM + (size_t)qrow0 * 768 + h * 96, 768, KV + h * 128, 1024, KV + h * 128 + 64, 1024, KR, OD + (size_t)qrow0 * 2048 + 1024 + h * 64, 2048, 128, b * SEQ, TL + b * CTXL, 132, 0, 0, 0, qb * 256 + wid * 32, ctab); }
    }
#endif
    if (!(part & 2)) return;
    const float* rpb = a->na_rpb + (size_t)l * 8 * 465;
    for (int u = bx; u < 512; u += F.G) { const int bh = (u & 7) + 8 * (u >> 8), rb = (u >> 3) & 31, b = bh >> 3, h = bh & 7; const int r0 = 4 * rb;
        {
            LAS float* rp = (LAS float*)(F.lds + att::RPB_OFF); const float* src = rpb + h * 465;
            for (int i = F.tid; i < 465; i += 512) rp[i] = src[i] * LOG2E;
        }
        att::na_unit(F.lds, P, O, b, h, r0); }
    if (with_ctx) for (int u = (F.G >= 32 ? bx - 16 : bx); u < 16; u += F.G) { if (u < 0) break; const int b = u >> 3, h = u & 7; const int qrow0 = TL + b * CTXL + wid * 32;
        att::attn_unit<64, true, false>(F.lds, P + (size_t)qrow0 * NPROJ + C_QA + h * 64, NPROJ, P + C_KA + h * 64, NPROJ, P + C_VA + h * 64, NPROJ, nullptr, O + (size_t)qrow0 * 2048 + h * 64, 2048, 0, 0, TL + b * CTXL, 4, 0, 0, 0, 0, ctab); }
}

template <int KC, int K, int LDB = K>
__device__ __forceinline__ f32x4 sg_block(const Frame& F, const bf16* __restrict__ A, int lda, const bf16* __restrict__ Bt, int rblk, int nblk) {
    constexpr int ROWB = (KC + 8) * 2, ABYTES = 32 * ROWB, STAGE = 96 * ROWB, PPR = KC / 8, RPP = 512 / PPR, NA_ = 32 / RPP, NB_ = 64 / RPP, NS = KC / 32, NCH = K / KC, PD = 3;
    const int tid = F.tid, lane = F.lane, wy = F.wave >> 2, wx = F.wave & 3;
    const int prow = tid / PPR, pc = tid % PPR;
    const bf16* ag = A + (size_t)(rblk + prow) * lda + 8 * pc;
    const bf16* bg = Bt + (size_t)(nblk + prow) * LDB + 8 * pc;
    LAS unsigned char* lds = F.lds;
    const unsigned la = prow * ROWB + pc * 16;
    const LAS unsigned char* ard = lds + (16 * wy + (lane & 15)) * ROWB + (lane >> 4) * 16;
    const LAS unsigned char* brd = lds + ABYTES + (16 * wx + (lane & 15)) * ROWB + (lane >> 4) * 16;
    f32x4 acc = {0.f, 0.f, 0.f, 0.f};
    u32x4 ra[PD + 1][NA_], rb[PD + 1][NB_];
#define SG_LOAD(c_) do { _Pragma("unroll") for (int i = 0; i < NA_; ++i) ra[(c_) % (PD + 1)][i] = *(const u32x4*)(ag + (size_t)(RPP * i) * lda + (c_) * KC); \
        _Pragma("unroll") for (int i = 0; i < NB_; ++i) rb[(c_) % (PD + 1)][i] = *(const u32x4*)(bg + (size_t)(RPP * i) * LDB + (c_) * KC); } while (0)
#define SG_STORE(c_) do { LAS unsigned char* b_ = lds + ((c_) & 1) * STAGE; _Pragma("unroll") for (int i = 0; i < NA_; ++i) *(LAS u32x4*)(b_ + la + i * RPP * ROWB) = ra[(c_) % (PD + 1)][i]; \
        _Pragma("unroll") for (int i = 0; i < NB_; ++i) *(LAS u32x4*)(b_ + ABYTES + la + i * RPP * ROWB) = rb[(c_) % (PD + 1)][i]; } while (0)
#pragma unroll
    for (int c = 0; c < PD && c < NCH; ++c) SG_LOAD(c);
    SG_STORE(0); __syncthreads();
#pragma unroll
    for (int c = 0; c < NCH; ++c) { const int st = c & 1;
        if (c + PD < NCH) SG_LOAD(c + PD);
        bf16x8 av[NS], bv[NS];
#pragma unroll
        for (int ks = 0; ks < NS; ++ks) { av[ks] = *(const LAS bf16x8*)(ard + st * STAGE + ks * 64); bv[ks] = *(const LAS bf16x8*)(brd + st * STAGE + ks * 64); }
#pragma unroll
        for (int ks = 0; ks < NS; ++ks) acc = __builtin_amdgcn_mfma_f32_16x16x32_bf16(av[ks], bv[ks], acc, 0, 0, 0);
        if (c + 1 < NCH) SG_STORE(c + 1);
        __syncthreads();
    }
#undef SG_LOAD
#undef SG_STORE
    return acc;
}
#define SG_BLOCKS(ncb) for (int blk_ = blockIdx.x; blk_ < 16 * (ncb); blk_ += gridDim.x)
#define SG_COORDS(ncb) const int rb_ = blk_ / (ncb), cb_ = blk_ % (ncb); const int rblk = TL + 32 * rb_, nblk = 64 * cb_; const int rowq = rblk + 16 * (F.wave >> 2) + 4 * (F.lane >> 4), col = nblk + 16 * (F.wave & 3) + (F.lane & 15); (void)rowq; (void)col;
__device__ __forceinline__ void sg_store4(bf16* O, int ldo, int rowq, int col, const f32x4& v) {
#pragma unroll
    for (int i = 0; i < 4; ++i) O[(size_t)(rowq + i) * ldo + col] = (bf16)f2bf(v[i]);
}
__device__ __forceinline__ void ctx_kvup(int l) { ArgP a = kargs(); Frame F = make_frame(); unsigned char* ws = a->ws; const bf16* P = (const bf16*)(ws + WS_PROJ); const float* RS = (const float*)(ws + WS_RS);
    const bf16* W = (const bf16*)(ws + WS_WOTHER + (size_t)l * WL_SIZE + WL_WUKV);
    SG_BLOCKS(16) { SG_COORDS(16) f32x4 acc = sg_block<256, 256>(F, P + C_CKV, NPROJ, W, rblk, nblk);
#pragma unroll
        for (int i = 0; i < 4; ++i) acc[i] *= RS[(size_t)(rowq + i) * 2 + 1];
        sg_store4((bf16*)(ws + WS_C), 1024, rowq, col, acc); } }
__device__ __forceinline__ void ctx_qup(int l) { ArgP a = kargs(); Frame F = make_frame(); unsigned char* ws = a->ws; const bf16* P = (const bf16*)(ws + WS_PROJ); const float* RS = (const float*)(ws + WS_RS);
    const bf16* W = (const bf16*)(ws + WS_WOTHER + (size_t)l * WL_SIZE + WL_WUQ);
    SG_BLOCKS(12) { SG_COORDS(12) f32x4 acc = sg_block<128, 384>(F, P + C_CQ, NPROJ, W, rblk, nblk);
#pragma unroll
        for (int i = 0; i < 4; ++i) acc[i] *= RS[(size_t)(rowq + i) * 2] * QS_MLA;
        sg_store4((bf16*)(ws + WS_D), 768, rowq, col, acc); } }
__device__ __forceinline__ void ctx_merge(int l) { ArgP a = kargs(); Frame F = make_frame(); unsigned char* ws = a->ws; const bf16* OB = (const bf16*)(ws + WS_O); const unsigned char* GATE8 = (const unsigned char*)((const bf16*)(ws + WS_PROJ) + C_GATE);
    const bf16* W = (const bf16*)(ws + WS_WOTHER + (size_t)l * WL_SIZE + WL_WBR);
    SG_BLOCKS(16) { SG_COORDS(16) f32x4 tot = {0.f, 0.f, 0.f, 0.f};
#pragma unroll
        for (int k = 0; k < 4; ++k) { const f32x4 acc = sg_block<256, 512, 2048>(F, OB + k * 512, 2048, W + k * 512, rblk, nblk);
#pragma unroll
            for (int i = 0; i < 4; ++i) tot[i] += acc[i] * (g8((unsigned)GATE8[(size_t)(rowq + i) * (NPROJ * 2) + k * 1024 + col]) * (1.f / 255.f)); }
        sg_store4((bf16*)(ws + WS_C), 1024, rowq, col, tot); } }
__device__ __forceinline__ void ctx_wout(int l) { ArgP a = kargs(); Frame F = make_frame(); unsigned char* ws = a->ws;
    const bf16* W = (const bf16*)(ws + WS_WOTHER + (size_t)l * WL_SIZE + WL_WOUT);
    SG_BLOCKS(16) { SG_COORDS(16) const f32x4 acc = sg_block<256, 1024>(F, (const bf16*)(ws + WS_C), 1024, W, rblk, nblk); sg_store4((bf16*)(ws + WS_D), 1024, rowq, col, acc); } }
__device__ __forceinline__ void ctx_ffn_down() { ArgP a = kargs(); Frame F = make_frame(); unsigned char* ws = a->ws;
    const bf16* W = (const bf16*)(ws + WS_WOTHER + WO_F2);
    SG_BLOCKS(16) { SG_COORDS(16) const f32x4 acc = sg_block<256, DFF>(F, (const bf16*)(ws + WS_PROJ), DFF, W, rblk, nblk); sg_store4((bf16*)(ws + WS_D), 1024, rowq, col, acc); } }

#define PH_BEGIN ArgP a = kargs(); unsigned char* ws = a->ws; LAS unsigned char* lds = make_frame().lds; const int G = gridDim.x, bx = blockIdx.x; (void)lds; (void)G; (void)bx; \
    unsigned char* wl = ws + WS_WOTHER + (size_t)l * WL_SIZE; (void)wl; bf16* PROJ = (bf16*)(ws + WS_PROJ); bf16* OB = (bf16*)(ws + WS_O); bf16* CB = (bf16*)(ws + WS_C); bf16* DB = (bf16*)(ws + WS_D); bf16* EB = (bf16*)(ws + WS_E); \
    float* RS = (float*)(ws + WS_RS); (void)PROJ; (void)OB; (void)CB; (void)DB; (void)EB; (void)RS;
__device__ __forceinline__ void ph_gemm1(int l, int flags) { PH_BEGIN (void)flags;
    { SchedCols S; S.init(T, 17, G, bx, CB, 1024, wl + WL_WIN, 1024, 0, C_GATE / 256, 16); EpiProj E{PROJ, NPROJ, QS_NA, 2, 1.f};
      pg8::gemm_phase(lds, pg8::Gemm{1024, 1024, 1024}, S, E); }
    { const int c2 = G == 256 ? (bx + 158) & 255 : bx;
      SchedCols S; S.init(T, 16, G, c2, ws + WS_H8, 512, wl + WL_WIN + (size_t)C_GATE * 1024 * 2 - (size_t)(C_GATE / 256) * (256 * 1024), 512, C_GATE / 256, 16, 0); EpiProj E{PROJ, NPROJ, QS_NA, 2, 1.f / W13_SCALE};
      pg8::gemm_phase<true>(lds, pg8::Gemm{512, 512, 512}, S, E); } }
__device__ __forceinline__ void ph_kvup(int l) { PH_BEGIN
    SchedStd S; S.init(TL, 1024, G, bx, PROJ + C_CKV, NPROJ, wl + WL_WUKV, 256); EpiRowScale E{CB, 1024, RS + 1, 2, 1.f};
    pg8::gemm_phase(lds, pg8::Gemm{256, NPROJ, 256}, S, E); }
__device__ __forceinline__ void ph_qup(int l, int Mx) { PH_BEGIN
    SchedStd S; S.init(Mx, 768, G, bx, PROJ + C_CQ, NPROJ, wl + WL_WUQ, 384); EpiRowScale E{DB, 768, RS, 2, QS_MLA};
    pg8::gemm_phase(lds, pg8::Gemm{384, NPROJ, 384}, S, E); }
__device__ __forceinline__ void ph_merge(int l, int Mx) { PH_BEGIN
    SchedStd S; S.init(Mx, 1024, G, bx, OB, 2048, wl + WL_WBR, 2048); EpiMergeCat E{CB, (const unsigned char*)(PROJ + C_GATE)};
    pg8::gemm_phase(lds, pg8::Gemm{2048, 2048, 2048}, S, E); }
__device__ __forceinline__ void ph_wout(int l, int Mx) { PH_BEGIN
    SchedStd S; S.init(Mx, 1024, G, bx, CB, 1024, wl + WL_WOUT, 1024); EpiRowScale E{DB, 1024, nullptr, 0, 1.f};
    pg8::gemm_phase(lds, pg8::Gemm{1024, 1024, 1024}, S, E); }
__device__ __forceinline__ void ph_ffn_up() { const int l = 0; PH_BEGIN
    SchedStd S; S.init(T, 2 * DFF, G, bx, CB, 1024, ws + WS_WOTHER + WO_F13, 1024); EpiSwiglu E{PROJ, DFF};
    pg8::gemm_phase(lds, pg8::Gemm{1024, 1024, 1024}, S, E); }
__device__ __forceinline__ void ph_ffn_down() { const int l = 0; PH_BEGIN
    SchedStd S; S.init(TL, 1024, G, bx, PROJ, DFF, ws + WS_WOTHER + WO_F2, DFF); EpiRowScale E{DB, 1024, nullptr, 0, 1.f};
    pg8::gemm_phase(lds, pg8::Gemm{DFF, DFF, DFF}, S, E); }
__device__ __forceinline__ void ph_moe_up() { const int l = 1; PH_BEGIN
    int pst[NEXP], npan; moe_panel_starts(ws, pst, npan);
    SchedMoe S; S.init(npan, 2 * DFE, G, bx, EB, 512, ws + WS_WMOE13, 512, pst); EpiSwigluF8 E{ws + WS_HIDM, DFE, 1.f / W13_SCALE};
    pg8::gemm_phase<true>(lds, pg8::Gemm{512, 512, 512}, S, E); }
__device__ __forceinline__ void ph_moe_down() { const int l = 1; PH_BEGIN
    int pst[NEXP], npan; moe_panel_starts(ws, pst, npan); const int nA = npan < 128 ? npan : 128;
    { SchedMoe S; S.init(nA, 1024, G, bx, ws + WS_HIDM, DFE / 2, ws + WS_WMOE2, DFE / 2, pst); EpiRowScale E{EB, 1024, (const float*)(ws + WS_SLOTW), 1, 1.f / W2_SCALE};
      pg8::gemm_phase<true>(lds, pg8::Gemm{DFE / 2, DFE / 2, DFE / 2}, S, E); }
    if (npan > nA) { SchedMoeSplit S; S.init(nA, npan - nA, G, bx, ws + WS_HIDM, ws + WS_WMOE2, pst); EpiSplitF32 E{(float*)(ws + WS_D), (const float*)(ws + WS_SLOTW), nA * 256, 1.f / W2_SCALE};
      pg8::gemm_phase<true>(lds, pg8::Gemm{DFE / 4, DFE / 2, DFE / 2}, S, E); } }

__global__ void __launch_bounds__(512, 2) dit_fwd(Args args_unused) {
    extern __shared__ __attribute__((aligned(16))) unsigned char lds_raw[];
    (void)args_unused;
    LAS unsigned char* lds0 = (LAS unsigned char*)lds_raw;
    volatile LAS unsigned* MISC = (volatile LAS unsigned*)(lds0 + MISC_OFF);
    for (int u = threadIdx.x; u < (LDS_BYTES - LDSCTL_OFF) / 4; u += 512) ((LAS unsigned*)(lds0 + LDSCTL_OFF))[u] = 0u;
    __syncthreads();
    XcdBarrier bar = xcd_barrier_post((unsigned*)(kargs()->ws + WS_CTL) + CW_BAR, MISC + 8);
#define GRID_BAR() xcd_barrier(bar)

#define REP(bit, stmt) do { const int n_ = 1 + ((kargs()->rep >> (bit)) & 1); for (int r_ = 0; r_ < n_; ++r_) { stmt; GRID_BAR(); } } while (0)
    REP(0, phase_prologue());
    REP(1, phase_norm_in());
    for (int l = 0; l < 2; ++l) {
        const int Mx = (l == 0) ? T : TL;
        REP(2, ph_gemm1(l, 0));
        REP(3, phase_prep(l));
        REP(4, (ph_kvup(l), ph_qup(l, TL), ctx_kvup(l), (l == 0 ? ctx_qup(l) : (void)0)));
        { const int n5 = 1 + ((kargs()->rep >> 5) & 1), n11 = 1 + ((kargs()->rep >> 11) & 1);
          for (int r_ = 0; r_ < n5; ++r_) phase_attention(l, l == 0, 1);
#ifdef ATT_DBG
          phase_attention(l, l == 0, 4);
#endif
          for (int r_ = 0; r_ < n11; ++r_) phase_attention(l, l == 0, 2);
          GRID_BAR(); }
        REP(6, (ph_merge(l, TL), (l == 0 ? ctx_merge(l) : (void)0)));
        REP(7, (ph_wout(l, TL), (l == 0 ? ctx_wout(l) : (void)0)));
        if (l == 0) {
            REP(8, (phase_resid<false, false, true, true>(T, WS_D, 0, 2, 1, 2, 0, 3, WS_C)));
            REP(9, ph_ffn_up());
            REP(10, (ph_ffn_down(), ctx_ffn_down()));
            phase_resid<false, false, false, true, true>(T, WS_D, 0, 5, 3, 4, 1, 0, WS_C);
            GRID_BAR();
        } else {
            phase_resid<false, true, false, true>(TL, WS_D, 1, 2, 5, 6, 1, 3, WS_C);
            __syncthreads();
            REP(12, moe_convert());
            REP(13, phase_moe_gather());
            REP(14, ph_moe_up());
            REP(15, ph_moe_down());
            phase_resid<true, false, false, false>(TL, WS_E, 1, 5, 7, 0, 0, 0, WS_C);
        }
    }
}

#ifndef REP_MASK
#define REP_MASK 0
#endif
extern "C" void kernel_launch(void* const* d_in, const int* in_sizes, int n_in, void* d_out, int out_size, void* d_ws, size_t ws_size, hipStream_t stream) {
    static int grid = 0;
    if (grid == 0) {
        if (n_in != 25 || out_size != TL * DM || ws_size < WS_END) { fprintf(stderr, "kernel_launch: unexpected problem (n_in %d, out %d, ws %zu)\n", n_in, out_size, ws_size); grid = -1; return; }
        int dev = 0, cus = 0, per_cu = 0;
        if (hipGetDevice(&dev) != hipSuccess || hipDeviceGetAttribute(&cus, hipDeviceAttributeMultiprocessorCount, dev) != hipSuccess) { grid = -1; return; }
        if (hipFuncSetAttribute((const void*)dit_fwd, hipFuncAttributeMaxDynamicSharedMemorySize, LDS_BYTES) != hipSuccess) { grid = -1; return; }
        if (hipOccupancyMaxActiveBlocksPerMultiprocessor(&per_cu, (const void*)dit_fwd, 512, LDS_BYTES) != hipSuccess || per_cu < 1) { fprintf(stderr, "kernel_launch: occupancy query says %d\n", per_cu); }
        (void)hipGetLastError();
        grid = cus;
    }
    if (grid < 0) return;
    if (hipMemsetAsync((char*)d_ws + WS_CTL, 0, CTL_ZERO_BYTES, stream) != hipSuccess) return;
    Args a{};
    const float** ap = (const float**)&a;
    for (int i = 0; i < 25; ++i) ap[i] = (const float*)d_in[i];
    a.out = (float*)d_out; a.ws = (unsigned char*)d_ws; a.rep = REP_MASK; a.pad = 0;
    hipLaunchKernelGGL(dit_fwd, dim3(grid), dim3(512), LDS_BYTES, stream, a);
}
```

```cpp
#include <hip/hip_runtime.h>
#include <cstdio>
#include <cstdint>

#define GAS __attribute__((address_space(1)))
#define LAS __attribute__((address_space(3)))
typedef unsigned short bf16;
typedef short bf16x8 __attribute__((ext_vector_type(8)));
typedef float f32x4 __attribute__((ext_vector_type(4)));
typedef float f32x16 __attribute__((ext_vector_type(16)));
typedef unsigned u32x4 __attribute__((ext_vector_type(4)));
typedef unsigned u32x2 __attribute__((ext_vector_type(2)));
typedef GAS unsigned gu32;
typedef int i32x4 __attribute__((ext_vector_type(4)));
typedef int i32x8 __attribute__((ext_vector_type(8)));

constexpr int TL = 16384, TC = 512, T = TL + TC, DM = 1024, SEQ = 8192, CTXL = 256;
constexpr int NPROJ = 8448;
constexpr int C_QA = 0, C_KA = 512, C_VA = 1024, C_UP = 1536, C_BG = 2048, C_CG = 2560, C_XC = 3072, C_GATE = 3584, C_CQ = 7680, C_CKV = 8064, C_KR = 8320;
constexpr int NREF = 8352;
constexpr int DFF = 2816, DFE = 3584, NEXP = 8;
constexpr int MAXPAN = 136;
constexpr float EPS = 1e-6f;
constexpr float LOG2E = 1.4426950408889634f;
constexpr float QS_NA = 0.125f * LOG2E;
constexpr float QS_MLA = 0.10206207261596577f * LOG2E;

constexpr size_t MiB = 1u << 20;
constexpr size_t WS_CTL = 0, CTL_ZERO_BYTES = 1 * MiB;
constexpr size_t WS_MOD = 1 * MiB;
constexpr size_t WS_ROPE = WS_MOD + 256 * 1024;
constexpr size_t WS_RS = WS_MOD + 512 * 1024;
constexpr size_t WS_ROUTE = 2 * MiB;
constexpr size_t WS_SLOTW = 2 * MiB + 512 * 1024;
constexpr size_t WS_TOK2SLOT = 2 * MiB + 768 * 1024;
constexpr size_t WS_BLKCNT = 2 * MiB + 960 * 1024;
constexpr size_t WS_KR = 3 * MiB;
constexpr size_t WS_XC = 5 * MiB;
constexpr size_t WS_WOTHER = 8 * MiB;
constexpr size_t WS_PROJ = 74 * MiB;
constexpr size_t WS_O = 347 * MiB;
constexpr size_t WS_H8 = WS_O;
constexpr size_t WS_C = 414 * MiB;
constexpr size_t WS_D = 447 * MiB;
constexpr size_t WS_E = 480 * MiB;
constexpr size_t WS_END = 548 * MiB;
constexpr size_t WS_WMOE13 = 8 * MiB;
constexpr size_t WS_WMOE2 = 120 * MiB;
constexpr size_t WS_HIDM = 176 * MiB;
constexpr size_t WL_WIN = 0, WL_WUQ = WL_WIN + (size_t)NPROJ * 1024 * 2, WL_WUKV = WL_WUQ + 768 * 384 * 2, WL_WPOOL = WL_WUKV + 1024 * 256 * 2,
                 WL_WBR = WL_WPOOL + 512 * 512 * 2, WL_WOUT = WL_WBR + (size_t)4 * 1024 * 512 * 2, WL_SIZE = WL_WOUT + 1024 * 1024 * 2;
constexpr size_t WO_F13 = 2 * WL_SIZE, WO_F2 = WO_F13 + (size_t)2 * DFF * 1024 * 2, WO_END = WO_F2 + (size_t)1024 * DFF * 2;
static_assert(WO_END <= 66 * MiB, "W_other fits");
static_assert(WS_PROJ + (size_t)T * NPROJ * 2 <= WS_O && WS_O + (size_t)T * 2048 * 2 <= WS_C && WS_C + (size_t)T * 1024 * 2 <= WS_D && WS_D + (size_t)T * 1024 * 2 <= WS_E, "map");
static_assert(WS_HIDM + (size_t)MAXPAN * 256 * DFE * 2 <= WS_C && WS_E + (size_t)MAXPAN * 256 * 1024 * 2 <= WS_END, "map2");
static_assert(WS_WMOE13 + (size_t)8 * 7168 * 1024 * 2 <= WS_WMOE2 && WS_WMOE2 + (size_t)8 * 1024 * DFE * 2 <= WS_HIDM, "map3");
constexpr int CW_TMO = 0, CW_BAR = 4096, CW_CNT = 16384;
constexpr size_t WS_GT = 480 * MiB;
__host__ __device__ __forceinline__ size_t gt_block(int k, int pm, int pn, int wr, int wc, int ai, int m) { return ((size_t)((((((k * 66 + pm) * 4 + pn) * 2 + wr) * 4 + wc) * 2 + ai) * 4 + m)) * 1024; }
__host__ __device__ __forceinline__ size_t gt_byte(int row, int k, int col) {
    const int pm = row >> 8, r = row & 255, pn = col >> 8, c = col & 255;
    return gt_block(k, pm, pn, (r >> 6) & 1, (c >> 5) & 3, r >> 7, (r >> 4) & 3) + (size_t)(((r & 15) + 16 * ((c >> 3) & 3)) * 16 + 8 * (c >> 7) + (c & 7)); }
static_assert(WS_GT == 480 * MiB && (size_t)4 * 66 * 4 * 64 * 1024 <= 68 * MiB, "gate tiles fit WS_E");

constexpr int RING_BYTES = 131072, LDSCTL_OFF = RING_BYTES, MISC_OFF = LDSCTL_OFF + 320, LDS_BYTES = 147456;

#define RLX_AGENT __ATOMIC_RELAXED, __HIP_MEMORY_SCOPE_AGENT
#define LDS_WAIT() asm volatile("s_waitcnt lgkmcnt(0)" ::: "memory")
__device__ __forceinline__ unsigned f2bf(float f) { unsigned u = __builtin_bit_cast(unsigned, f); return (u + 0x7fffu + ((u >> 16) & 1u)) >> 16; }
__device__ __forceinline__ unsigned pk2(float lo, float hi) { return f2bf(lo) | (f2bf(hi) << 16); }
__device__ __forceinline__ float bflo(unsigned u) { return __builtin_bit_cast(float, u << 16); }
__device__ __forceinline__ float bfhi(unsigned u) { return __builtin_bit_cast(float, u & 0xffff0000u); }
typedef float f32x2_t __attribute__((ext_vector_type(2))); typedef __bf16 bf16x2_t __attribute__((ext_vector_type(2)));
__device__ __forceinline__ unsigned cvt_pk_bf16(float lo, float hi) { f32x2_t v = {lo, hi}; bf16x2_t b = __builtin_convertvector(v, bf16x2_t); return __builtin_bit_cast(unsigned, b); }
__device__ __forceinline__ float clamp_f8(float x) { return __builtin_amdgcn_fmed3f(x, -448.f, 448.f); }
__device__ __forceinline__ unsigned pk4_fp8(float a, float b, float c, float d) { int w = __builtin_amdgcn_cvt_pk_fp8_f32(clamp_f8(a), clamp_f8(b), 0, false); w = __builtin_amdgcn_cvt_pk_fp8_f32(clamp_f8(c), clamp_f8(d), w, true); return (unsigned)w; }
constexpr float W13_SCALE = 32.f, W2_SCALE = 64.f;
__device__ __forceinline__ float wave_sum(float v) {
#pragma unroll
    for (int o = 1; o < 64; o <<= 1) v += __shfl_xor(v, o);
    return v;
}
__device__ __forceinline__ float fast_exp2(float x) { return __builtin_amdgcn_exp2f(x); }
__device__ __forceinline__ float fast_rcp(float x) { return __builtin_amdgcn_rcpf(x); }
__device__ __forceinline__ float sigmoidf_(float x) { return fast_rcp(1.f + fast_exp2(-x * LOG2E)); }

namespace pg8 {
constexpr int BM = 256, BK = 64, HALF = 128, HTB = HALF * BK * 2, NXCD = 8, WGM = 8;
__host__ __device__ __forceinline__ int lds_byte(int r, int c) { const int st = (r >> 4) * 2 + (c >> 5), rr = r & 15, cc = c & 31, ob = rr * 64 + cc * 2; return st * 1024 + (ob ^ (((ob >> 9) & 1) << 5)); }
__host__ __device__ __forceinline__ void stage_rc(int b, int& R, int& C) { const int st = b / 1024, sb = b % 1024, swz = sb ^ (((sb >> 9) & 1) << 5); R = (st >> 1) * 16 + swz / 64; C = (st & 1) * 32 + (swz % 64) / 2; }
__host__ __device__ __forceinline__ int perm32(int rho) { const int n = rho >> 4, i = rho & 15; return 8 * (i >> 2) + 4 * n + (i & 3); }
struct Unit { int pm, pn, aux; };
struct Gemm { int K; int lda; int ldb; };

struct StaticOrder {
    int nM, nN, nwg, G, c;
    __device__ void init(int M, int N, int G_, int c_) { nM = M / BM; nN = N / BM; nwg = nM * nN; G = G_; c = c_; }
    __device__ bool next(int i, Unit& u) const {
        const long L = (long)i * G + c; if (L >= nwg) return false;
        int wgid = (int)L; { const int q = nwg / NXCD, r = nwg % NXCD, xcd = wgid % NXCD, off = wgid / NXCD; wgid = (xcd < r ? xcd * (q + 1) : r * (q + 1) + (xcd - r) * q) + off; }
        const int nig = WGM * nN, gid = wgid / nig, fm = gid * WGM, gsz = (nM - fm) < WGM ? (nM - fm) : WGM;
        u.pm = fm + ((wgid % nig) % gsz); u.pn = (wgid % nig) / gsz; return true;
    }
};

__device__ __forceinline__ i32x8 cat8(const bf16x8& lo, const bf16x8& hi) { return __builtin_shufflevector(__builtin_bit_cast(i32x4, lo), __builtin_bit_cast(i32x4, hi), 0, 1, 2, 3, 4, 5, 6, 7); }
__device__ __forceinline__ void mfma_f8(f32x4& acc, const i32x8 a, const i32x8 b) { asm volatile("v_mfma_f32_16x16x128_f8f6f4 %0, %1, %2, %0" : "+v"(acc) : "v"(a), "v"(b)); }
__device__ __forceinline__ void mfma_f8_drain() { asm volatile("s_nop 7\n\ts_nop 7\n\ts_nop 7" ::: "memory"); }
template <bool F8 = false, class Epi, class Sched>
__device__ __forceinline__ void gemm_phase(LAS unsigned char* lds, const Gemm g, const Sched& S, const Epi& E) {
    int tid = threadIdx.x; asm volatile("" : "+v"(tid));
    const int wid = __builtin_amdgcn_readfirstlane(tid >> 6), lane = tid & 63, wr = wid >> 2, wc = wid & 3, fr = lane & 15, fq = lane >> 4;
    const int K = g.K, lda = g.lda, ldb = g.ldb, nt = K / BK;
    unsigned voffA[2], voffB[2];
#pragma unroll
    for (int i = 0; i < 2; ++i) { int R, C; stage_rc(tid * 16 + i * 8192, R, C); const int Rb = (R & ~31) + perm32(R & 31);
        voffA[i] = (unsigned)(R * lda + C) * 2u; voffB[i] = (unsigned)(Rb * ldb + C) * 2u; }
    const size_t kstep = (size_t)(BK * 2);
    const size_t hstepA = (size_t)HALF * lda * 2, hstepB = (size_t)HALF * ldb * 2;
    const unsigned ldsw = (unsigned)wid * 1024u;
    const int aoff = lds_byte(wr * 64 + fr, fq * 8), boff = lds_byte(wc * 32 + fr, fq * 8);
#define PG8_SA(b, h) (((b) * 2 + (h)) * HTB)
#define PG8_SB(b, h) ((4 + (b) * 2 + (h)) * HTB)
#define PG8_STAGE(bufoff, gbase, voff) do { _Pragma("unroll") for (int _i = 0; _i < 2; ++_i) \
        __builtin_amdgcn_global_load_lds((const unsigned*)((const char*)(gbase) + (voff)[_i]), (LAS unsigned*)(lds + (bufoff) + ldsw + _i * 8192), 16, 0, 0); } while (0)
#define PG8_LDA(dst, b, h) do { _Pragma("unroll") for (int m = 0; m < 4; ++m) _Pragma("unroll") for (int k = 0; k < 2; ++k) dst[m][k] = *(const LAS bf16x8*)(lds + PG8_SA(b, h) + aoff + m * 2048 + k * 1024); } while (0)
#define PG8_LDB(dst, b, h) do { _Pragma("unroll") for (int n = 0; n < 2; ++n) _Pragma("unroll") for (int k = 0; k < 2; ++k) dst[n][k] = *(const LAS bf16x8*)(lds + PG8_SB(b, h) + boff + n * 2048 + k * 1024); } while (0)
#define PG8_MMA(ai, bj, At, Bt) do { __builtin_amdgcn_s_setprio(1); _Pragma("unroll") for (int m = 0; m < 4; ++m) _Pragma("unroll") for (int n = 0; n < 2; ++n) { \
        if constexpr (F8) mfma_f8(acc[ai][bj][m][n], cat8(Bt[n][0], Bt[n][1]), cat8(At[m][0], At[m][1])); \
        else { _Pragma("unroll") for (int k = 0; k < 2; ++k) acc[ai][bj][m][n] = __builtin_amdgcn_mfma_f32_16x16x32_bf16(Bt[n][k], At[m][k], acc[ai][bj][m][n], 0, 0, 0); } } __builtin_amdgcn_s_setprio(0); } while (0)
#define PG8_WAIT_V(n) asm volatile("s_waitcnt vmcnt(" #n ")" ::: "memory")
#define PG8_WAIT_L(n) asm volatile("s_waitcnt lgkmcnt(" #n ")" ::: "memory")
#define PG8_BAR __builtin_amdgcn_s_barrier()
#define PG8_SCHED __builtin_amdgcn_sched_barrier(0)
    Unit cur, nxt; int ui = 0;
    if (!S.next(0, cur)) return;
    f32x4 acc[2][2][4][2];
#pragma unroll
    for (int a = 0; a < 2; ++a)
#pragma unroll
        for (int b = 0; b < 2; ++b)
#pragma unroll
            for (int m = 0; m < 4; ++m)
#pragma unroll
                for (int n = 0; n < 2; ++n) acc[a][b][m][n] = (f32x4){0.f, 0.f, 0.f, 0.f};
    bf16x8 At[4][2], B0[2][2], B1[2][2];
    const char* cA; const char* cB; S.bases(cur, cA, cB);
    PG8_STAGE(PG8_SB(0, 0), cB, voffB); PG8_STAGE(PG8_SB(0, 1), cB + hstepB, voffB); PG8_STAGE(PG8_SA(0, 0), cA, voffA); PG8_STAGE(PG8_SA(0, 1), cA + hstepA, voffA);
    if (wr == 1) PG8_BAR;
    PG8_WAIT_V(2); PG8_BAR;
    PG8_STAGE(PG8_SB(1, 0), cB + kstep, voffB); PG8_STAGE(PG8_SA(1, 0), cA + kstep, voffA); PG8_STAGE(PG8_SB(1, 1), cB + hstepB + kstep, voffB);
    PG8_WAIT_V(6); PG8_BAR;
    for (;;) {
        const bool has_next = S.next(ui + 1, nxt);
        const char* nA = cA; const char* nB = cB; if (has_next) S.bases(nxt, nA, nB);
        for (int t = 0; t < nt; t += 2) {
            const bool last = (t == nt - 2);
            const char* a1 = cA + (size_t)(t + 1) * kstep;
            const char* a2 = last ? nA : cA + (size_t)(t + 2) * kstep; const char* b2 = last ? nB : cB + (size_t)(t + 2) * kstep;
            const char* a3 = a2 + kstep; const char* b3 = b2 + kstep;
            PG8_LDB(B0, 0, 0); PG8_LDB(B1, 0, 1); PG8_SCHED; PG8_LDA(At, 0, 0); PG8_STAGE(PG8_SA(1, 1), a1 + hstepA, voffA);
            PG8_WAIT_V(8); PG8_WAIT_L(0); PG8_BAR; PG8_MMA(0, 0, At, B0); PG8_MMA(0, 1, At, B1); PG8_BAR; PG8_SCHED;
            PG8_LDA(At, 0, 1); PG8_STAGE(PG8_SB(0, 0), b2, voffB); PG8_STAGE(PG8_SB(0, 1), b2 + hstepB, voffB); PG8_STAGE(PG8_SA(0, 0), a2, voffA);
            PG8_WAIT_V(8); PG8_WAIT_L(0); PG8_BAR; PG8_MMA(1, 0, At, B0); PG8_MMA(1, 1, At, B1); PG8_BAR; PG8_SCHED;
            PG8_LDB(B0, 1, 0); PG8_LDB(B1, 1, 1); PG8_SCHED; PG8_LDA(At, 1, 0); PG8_STAGE(PG8_SA(0, 1), a2 + hstepA, voffA);
            PG8_WAIT_V(8); PG8_WAIT_L(0); PG8_BAR; PG8_MMA(0, 0, At, B0); PG8_MMA(0, 1, At, B1); PG8_BAR; PG8_SCHED;
            PG8_LDA(At, 1, 1); PG8_STAGE(PG8_SB(1, 0), b3, voffB); PG8_STAGE(PG8_SB(1, 1), b3 + hstepB, voffB); PG8_STAGE(PG8_SA(1, 0), a3, voffA);
            PG8_WAIT_V(8); PG8_WAIT_L(0); PG8_BAR; PG8_MMA(1, 0, At, B0); PG8_MMA(1, 1, At, B1); PG8_BAR; PG8_SCHED;
            if constexpr (Epi::SEG > 0) { if ((t + 2) % Epi::SEG == 0 && t + 2 < nt) { E.segment(acc, cur, (t + 2) / Epi::SEG - 1, wr, wc, fr, fq); PG8_SCHED; } }
        }
        if (wr == 0) PG8_BAR;
        if constexpr (F8) mfma_f8_drain();
        E(acc, cur, wr, wc, fr, fq);
        if (!has_next) break;
#pragma unroll
        for (int a = 0; a < 2; ++a)
#pragma unroll
            for (int b = 0; b < 2; ++b)
#pragma unroll
                for (int m = 0; m < 4; ++m)
#pragma unroll
                    for (int n = 0; n < 2; ++n) acc[a][b][m][n] = (f32x4){0.f, 0.f, 0.f, 0.f};
        cur = nxt; cA = nA; cB = nB; ++ui;
        if (wr == 1) PG8_BAR;
    }
    PG8_WAIT_V(0);
    PG8_BAR;
#undef PG8_SA
#undef PG8_SB
#undef PG8_STAGE
#undef PG8_LDA
#undef PG8_LDB
#undef PG8_MMA
#undef PG8_WAIT_V
#undef PG8_WAIT_L
#undef PG8_BAR
#undef PG8_SCHED
}
}
using pg8::Unit;

struct SchedStd {
    pg8::StaticOrder so; const char* A; const char* B; size_t tA, tB;
    __device__ void init(int M, int N, int G, int c, const void* A_, int lda, const void* B_, int K) { so.init(M, N, G, c); A = (const char*)A_; B = (const char*)B_; tA = (size_t)256 * lda * 2; tB = (size_t)256 * K * 2; }
    __device__ __forceinline__ bool next(int i, Unit& u) const { u.aux = 0; return so.next(i, u); }
    __device__ __forceinline__ void bases(const Unit& u, const char*& a, const char*& b) const { a = A + (size_t)u.pm * tA; b = B + (size_t)u.pn * tB; }
};
struct SchedCols {
    pg8::StaticOrder so; const char* A; const char* B; size_t tA, tB; int pn0, split, skip;
    __device__ void init(int M, int ntiles, int G, int c, const void* A_, int lda, const void* B_, int K, int pn0_, int split_, int skip_) { so.init(M, ntiles * 256, G, c); A = (const char*)A_; B = (const char*)B_; tA = (size_t)256 * lda * 2; tB = (size_t)256 * K * 2; pn0 = pn0_; split = split_; skip = skip_; }
    __device__ __forceinline__ bool next(int i, Unit& u) const { u.aux = 0; if (!so.next(i, u)) return false; u.pn = u.pn < split ? u.pn + pn0 : u.pn + pn0 + skip; return true; }
    __device__ __forceinline__ void bases(const Unit& u, const char*& a, const char*& b) const { a = A + (size_t)u.pm * tA; b = B + (size_t)u.pn * tB; }
};
struct SchedMoe {
    pg8::StaticOrder so; const char* A; const char* B; size_t tA, tB; int nN; int pst[NEXP];
    __device__ void init(int npan, int N, int G, int c, const void* A_, int lda, const void* B_, int K, const int* pst_) { so.init(npan * 256, N, G, c); nN = N / 256; A = (const char*)A_; B = (const char*)B_; tA = (size_t)256 * lda * 2; tB = (size_t)256 * K * 2;
#pragma unroll
        for (int e = 0; e < NEXP; ++e) pst[e] = pst_[e]; }
    __device__ __forceinline__ bool next(int i, Unit& u) const { if (!so.next(i, u)) return false; int e = 0;
#pragma unroll
        for (int j = 1; j < NEXP; ++j) e += (u.pm >= pst[j]) ? 1 : 0;
        u.aux = e; return true; }
    __device__ __forceinline__ void bases(const Unit& u, const char*& a, const char*& b) const { a = A + (size_t)u.pm * tA; b = B + ((size_t)u.aux * nN + u.pn) * tB; }
};

struct SchedMoeSplit {
    const char* A; const char* B; int p0, nun, G, c; int pst[NEXP];
    __device__ void init(int p0_, int pl, int G_, int c_, const void* A_, const void* B_, const int* pst_) { p0 = p0_; nun = pl * 8; G = G_; c = c_; A = (const char*)A_; B = (const char*)B_;
#pragma unroll
        for (int e = 0; e < NEXP; ++e) pst[e] = pst_[e]; }
    __device__ __forceinline__ bool next(int i, Unit& u) const { const int L = i * G + c; if (L >= nun) return false; u.pn = (L >> 1) & 3; u.pm = p0 + (L >> 3); int e = 0;
#pragma unroll
        for (int j = 1; j < NEXP; ++j) e += (u.pm >= pst[j]) ? 1 : 0;
        u.aux = e + 8 * (L & 1); return true; }
    __device__ __forceinline__ void bases(const Unit& u, const char*& a, const char*& b) const { const int ks = u.aux >> 3, e = u.aux & 7;
        a = A + (size_t)u.pm * (256 * DFE) + ks * (DFE / 2); b = B + ((size_t)e * 4 + u.pn) * (256 * DFE) + ks * (DFE / 2); }
};

typedef f32x4 AccT[2][2][4][2];
__device__ __forceinline__ u32x4 pack8(const f32x4& v0, const f32x4& v1) { u32x4 w; w.x = cvt_pk_bf16(v0[0], v0[1]); w.y = cvt_pk_bf16(v0[2], v0[3]); w.z = cvt_pk_bf16(v1[0], v1[1]); w.w = cvt_pk_bf16(v1[2], v1[3]); return w; }

__device__ __forceinline__ float sig255(float acc, float nsc) { const float e = fast_exp2(fminf(acc * nsc, 7.98f)); return fast_rcp(__builtin_fmaf(e, 1.f / 255.f, 1.f / 255.f)); }
__device__ __forceinline__ unsigned pk4_u8(float a, float b, float c, float d) { unsigned w = __builtin_amdgcn_cvt_pk_u8_f32(a, 0, 0u); w = __builtin_amdgcn_cvt_pk_u8_f32(b, 1, w); w = __builtin_amdgcn_cvt_pk_u8_f32(c, 2, w); return __builtin_amdgcn_cvt_pk_u8_f32(d, 3, w); }
struct EpiProj {
    static constexpr int SEG = 0;
    bf16* O; int ldc; float s0; int npn0; float gsc; unsigned char* GT;
    __device__ __forceinline__ void operator()(const AccT& acc, const Unit& u, int wr, int wc, int fr, int fq) const {
        const int row0 = u.pm * 256 + wr * 64 + fr, col0 = u.pn * 256 + wc * 32 + 8 * fq; const float sc = ((u.pn < npn0) ? s0 : 1.f) * gsc;
        if (u.pn >= C_GATE / 256 && u.pn < (C_GATE + 4096) / 256) {
            const int pg_ = u.pn - C_GATE / 256; const float nsc = -gsc * LOG2E; unsigned char* gl = GT + (fr + 16 * fq) * 16;
#pragma unroll
            for (int ai = 0; ai < 2; ++ai)
#pragma unroll
                for (int m = 0; m < 4; ++m) { const f32x4 a0 = acc[ai][0][m][0], b0 = acc[ai][0][m][1], a1 = acc[ai][1][m][0], b1 = acc[ai][1][m][1]; u32x4 w;
                    w.x = pk4_u8(sig255(a0[0], nsc), sig255(a0[1], nsc), sig255(a0[2], nsc), sig255(a0[3], nsc)); w.y = pk4_u8(sig255(b0[0], nsc), sig255(b0[1], nsc), sig255(b0[2], nsc), sig255(b0[3], nsc));
                    w.z = pk4_u8(sig255(a1[0], nsc), sig255(a1[1], nsc), sig255(a1[2], nsc), sig255(a1[3], nsc)); w.w = pk4_u8(sig255(b1[0], nsc), sig255(b1[1], nsc), sig255(b1[2], nsc), sig255(b1[3], nsc));
                    *(u32x4*)(gl + gt_block(pg_ >> 2, u.pm, pg_ & 3, wr, wc, ai, m)) = w; }
            return;
        }
#pragma unroll
        for (int ai = 0; ai < 2; ++ai)
#pragma unroll
            for (int m = 0; m < 4; ++m) { bf16* rowp = O + (size_t)(row0 + ai * 128 + m * 16) * ldc + col0;
#pragma unroll
                for (int bj = 0; bj < 2; ++bj) *(u32x4*)(rowp + bj * 128) = pack8(acc[ai][bj][m][0] * sc, acc[ai][bj][m][1] * sc); }
    }
};
struct EpiRowScale {
    static constexpr int SEG = 0;
    bf16* O; int ldc; const float* rs; int rstride; float mul;
    __device__ __forceinline__ void operator()(const AccT& acc, const Unit& u, int wr, int wc, int fr, int fq) const {
        const int row0 = u.pm * 256 + wr * 64 + fr, col0 = u.pn * 256 + wc * 32 + 8 * fq;
        float scv[2][4];
#pragma unroll
        for (int ai = 0; ai < 2; ++ai)
#pragma unroll
            for (int m = 0; m < 4; ++m) scv[ai][m] = mul;
        if (rs) {
            float lv[2][4];
#pragma unroll
            for (int ai = 0; ai < 2; ++ai)
#pragma unroll
                for (int m = 0; m < 4; ++m) lv[ai][m] = rs[(size_t)(row0 + ai * 128 + m * 16) * rstride];
#pragma unroll
            for (int ai = 0; ai < 2; ++ai)
#pragma unroll
                for (int m = 0; m < 4; ++m) scv[ai][m] = lv[ai][m] * mul;
        }
        asm volatile("" ::: "memory");
#pragma unroll
        for (int ai = 0; ai < 2; ++ai)
#pragma unroll
            for (int m = 0; m < 4; ++m) { const int row = row0 + ai * 128 + m * 16; const float sc = scv[ai][m]; bf16* rowp = O + (size_t)row * ldc + col0;
#pragma unroll
                for (int bj = 0; bj < 2; ++bj) *(u32x4*)(rowp + bj * 128) = pack8(acc[ai][bj][m][0] * sc, acc[ai][bj][m][1] * sc); }
    }
};
__device__ __forceinline__ float g8(unsigned b) { return (float)b; }
struct EpiMergeCat {
    static constexpr int SEG = 8;
    bf16* MG; const unsigned char* GT;
    __device__ __forceinline__ static float rat(unsigned a, unsigned b, int sh) { return g8((a >> sh) & 255u) * fast_rcp(g8((b >> sh) & 255u)); }
    __device__ __forceinline__ void segment(AccT& acc, const Unit& u, int sgi, int wr, int wc, int fr, int fq) const {
        const unsigned char* gl = GT + (fr + 16 * fq) * 16;
#pragma unroll
        for (int ai = 0; ai < 2; ++ai) { u32x4 ga[4], gb[4];
#pragma unroll
            for (int m = 0; m < 4; ++m) { ga[m] = *(const u32x4*)(gl + gt_block(sgi, u.pm, u.pn, wr, wc, ai, m)); gb[m] = *(const u32x4*)(gl + gt_block(sgi + 1, u.pm, u.pn, wr, wc, ai, m)); }
#pragma unroll
            for (int m = 0; m < 4; ++m) { const u32x4 a = ga[m], b = gb[m];
#pragma unroll
                for (int bj = 0; bj < 2; ++bj) { const unsigned a0 = bj ? a.z : a.x, a1 = bj ? a.w : a.y, b0 = bj ? b.z : b.x, b1 = bj ? b.w : b.y;
                    f32x4& v0 = acc[ai][bj][m][0]; f32x4& v1 = acc[ai][bj][m][1];
                    v0[0] *= rat(a0, b0, 0); v0[1] *= rat(a0, b0, 8); v0[2] *= rat(a0, b0, 16); v0[3] *= rat(a0, b0, 24);
                    v1[0] *= rat(a1, b1, 0); v1[1] *= rat(a1, b1, 8); v1[2] *= rat(a1, b1, 16); v1[3] *= rat(a1, b1, 24); } }
            asm volatile("" ::: "memory"); __builtin_amdgcn_sched_barrier(0);
        }
    }
    __device__ __forceinline__ void operator()(const AccT& acc, const Unit& u, int wr, int wc, int fr, int fq) const {
        const int row0 = u.pm * 256 + wr * 64 + fr, col0 = u.pn * 256 + wc * 32 + 8 * fq; constexpr float I255 = 1.f / 255.f;
        const unsigned char* gl = GT + (fr + 16 * fq) * 16;
#pragma unroll
        for (int ai = 0; ai < 2; ++ai) { u32x4 gw[4];
#pragma unroll
            for (int m = 0; m < 4; ++m) gw[m] = *(const u32x4*)(gl + gt_block(3, u.pm, u.pn, wr, wc, ai, m));
#pragma unroll
            for (int m = 0; m < 4; ++m) { const int row = row0 + ai * 128 + m * 16; const u32x4 g = gw[m];
#pragma unroll
                for (int bj = 0; bj < 2; ++bj) { const unsigned g0 = bj ? g.z : g.x, g1 = bj ? g.w : g.y; const int col = col0 + bj * 128;
                    f32x4 v0 = acc[ai][bj][m][0], v1 = acc[ai][bj][m][1];
                    v0[0] *= g8(g0 & 255u) * I255; v0[1] *= g8((g0 >> 8) & 255u) * I255; v0[2] *= g8((g0 >> 16) & 255u) * I255; v0[3] *= g8(g0 >> 24) * I255;
                    v1[0] *= g8(g1 & 255u) * I255; v1[1] *= g8((g1 >> 8) & 255u) * I255; v1[2] *= g8((g1 >> 16) & 255u) * I255; v1[3] *= g8(g1 >> 24) * I255;
                    *(u32x4*)(MG + (size_t)row * 1024 + col) = pack8(v0, v1); } }
            asm volatile("" ::: "memory");
        }
    }
};
struct EpiSplitF32 {
    static constexpr int SEG = 0;
    float* SLAB; const float* rs; int row_base; float mul;
    __device__ __forceinline__ void operator()(const AccT& acc, const Unit& u, int wr, int wc, int fr, int fq) const {
        const int row0 = u.pm * 256 + wr * 64 + fr, col0 = u.pn * 256 + wc * 32 + 8 * fq; float* sl = SLAB + (size_t)(u.aux >> 3) * (8 * 256 * 1024);
        float scv[2][4];
#pragma unroll
        for (int ai = 0; ai < 2; ++ai)
#pragma unroll
            for (int m = 0; m < 4; ++m) scv[ai][m] = rs[row0 + ai * 128 + m * 16] * mul;
        asm volatile("" ::: "memory");
#pragma unroll
        for (int ai = 0; ai < 2; ++ai)
#pragma unroll
            for (int m = 0; m < 4; ++m) { const int row = row0 + ai * 128 + m * 16; const float sc = scv[ai][m]; float* rowp = sl + (size_t)(row - row_base) * 1024 + col0;
#pragma unroll
                for (int bj = 0; bj < 2; ++bj) { *(f32x4*)(rowp + bj * 128) = acc[ai][bj][m][0] * sc; *(f32x4*)(rowp + bj * 128 + 4) = acc[ai][bj][m][1] * sc; } }
    }
};
struct EpiSwiglu {
    static constexpr int SEG = 0;
    bf16* H; int ldh;
    __device__ __forceinline__ void operator()(const AccT& acc, const Unit& u, int wr, int wc, int fr, int fq) const {
        const int row0 = u.pm * 256 + wr * 64 + fr, col0 = u.pn * 128 + wc * 32 + 8 * fq;
#pragma unroll
        for (int ai = 0; ai < 2; ++ai)
#pragma unroll
            for (int m = 0; m < 4; ++m) { const int row = row0 + ai * 128 + m * 16; f32x4 v[2];
#pragma unroll
                for (int n = 0; n < 2; ++n)
#pragma unroll
                    for (int e = 0; e < 4; ++e) { const float a = acc[ai][0][m][n][e]; v[n][e] = a * sigmoidf_(a) * acc[ai][1][m][n][e]; }
                *(u32x4*)(H + (size_t)row * ldh + col0) = pack8(v[0], v[1]); }
    }
};

struct EpiSwigluF8 {
    static constexpr int SEG = 0;
    unsigned char* H; int ldh; float s;
    __device__ __forceinline__ void operator()(const AccT& acc, const Unit& u, int wr, int wc, int fr, int fq) const {
        const int row0 = u.pm * 256 + wr * 64 + fr, col0 = u.pn * 128 + wc * 32 + 8 * fq; const float nsc = -s * LOG2E, k2 = 1.f / (s * s);
#pragma unroll
        for (int ai = 0; ai < 2; ++ai)
#pragma unroll
            for (int m = 0; m < 4; ++m) { const int row = row0 + ai * 128 + m * 16; f32x4 v[2];
#pragma unroll
                for (int n = 0; n < 2; ++n)
#pragma unroll
                    for (int e = 0; e < 4; ++e) { const float A = acc[ai][0][m][n][e], ex = fast_exp2(A * nsc); v[n][e] = (A * acc[ai][1][m][n][e]) * fast_rcp(__builtin_fmaf(ex, k2, k2)); }
                u32x2 w; w.x = pk4_fp8(v[0][0], v[0][1], v[0][2], v[0][3]); w.y = pk4_fp8(v[1][0], v[1][1], v[1][2], v[1][3]);
                *(u32x2*)(H + (size_t)row * ldh + col0) = w; }
    }
};

namespace att {
constexpr int KSTR = 208, VSTR = 144, KT_BYTES = 64 * KSTR, VT_BYTES = 64 * VSTR, V_OFF = 3 * KT_BYTES;
constexpr int VROW = 192, VI_BYTES = 64 * VROW, RPB_OFF = V_OFF + 2 * VI_BYTES;
typedef short s16x4 __attribute__((ext_vector_type(4)));
__device__ __forceinline__ bf16x8 vtr8(const LAS unsigned char* p) {
    const s16x4 a = __builtin_amdgcn_ds_read_tr16_b64_v4i16((LAS s16x4*)p), b = __builtin_amdgcn_ds_read_tr16_b64_v4i16((LAS s16x4*)(p + 4 * VROW));
    return (bf16x8){a.x, a.y, a.z, a.w, b.x, b.y, b.z, b.w}; }
constexpr float NEG = -1e30f;
template <int DQK, bool NA, bool ROPE, int DBG = 0>
__device__ __forceinline__ void attn_unit(LAS unsigned char* lds, const bf16* __restrict__ Qw, int ldq, const bf16* __restrict__ Kb, int ldk, const bf16* __restrict__ Vb, int ldv,
                                          const bf16* __restrict__ KRb, bf16* Ow, int ldo, int nloc, int loc0, int ctx0, int nt, int wst, int drow0, int cq, int tq0, const float* __restrict__ ctab) {
    int tid = threadIdx.x; asm volatile("" : "+v"(tid));
    const int lane = tid & 63, q = lane & 31, h = lane >> 5;
    constexpr int NK = DQK / 16;
    bf16x8 qf[NK];
#pragma unroll
    for (int kk = 0; kk < NK; ++kk) qf[kk] = *(const bf16x8*)(Qw + (size_t)q * ldq + kk * 16 + h * 8);
    if constexpr (ROPE) {
        const int tq = tq0 + q;
#pragma unroll
        for (int k2 = 0; k2 < 2; ++k2) { const int pos = k2 == 0 ? (tq >> 6) : (tq & 63); const f32x4 cs = *(const f32x4*)(ctab + pos * 8 + 4 * h), sn = *(const f32x4*)(ctab + 1024 + pos * 8 + 4 * h);
            u32x4 w = __builtin_bit_cast(u32x4, qf[4 + k2]);
#pragma unroll
            for (int i = 0; i < 4; ++i) { const float x0 = bflo(w[i]), x1 = bfhi(w[i]); w[i] = pk2(x0 * cs[i] - x1 * sn[i], x0 * sn[i] + x1 * cs[i]); }
            qf[4 + k2] = __builtin_bit_cast(bf16x8, w); }
    }
    float lsum = 0.f; f32x16 o0 = {}, o1 = {};
    f32x16 negm = {};
    const int kkey = tid >> 3, kc = tid & 7, vkey = tid & 63, vc = tid >> 6, rkey = (tid >> 2) & 63, rc = tid & 3;
    const int pk = (q & 3) | (((q >> 3) & 1) << 2) | (((q >> 2) & 1) << 3) | (q & 16);
    const LAS float* rpbL = (const LAS float*)(lds + RPB_OFF);
    const LAS unsigned char* kfr = lds + pk * KSTR + h * 16;
    const LAS unsigned char* vfr = lds + V_OFF + (8 * h + ((lane & 15) >> 2)) * VROW + (16 * ((lane >> 4) & 1) + 4 * (lane & 3)) * 2;
    int cs_ = cq - 8; cs_ = cs_ < 0 ? 0 : (cs_ > 48 ? 48 : cs_);
    u32x4 rk = {0u, 0u, 0u, 0u}, rv = {0u, 0u, 0u, 0u}, rr = {0u, 0u, 0u, 0u};
#define ATT_ROW(t) (((t) < nloc) ? loc0 + 64 * (t) : ctx0 + 64 * ((t) - nloc))
#define ATT_LOADK(t) do { const int r0_ = ATT_ROW(t); rk = *(const u32x4*)(Kb + (size_t)(r0_ + kkey) * ldk + 8 * kc); if (DQK == 96 && tid < 256) rr = *(const u32x4*)(KRb + (size_t)(r0_ + rkey) * 32 + 8 * rc); } while (0)
#define ATT_LOADV(t) do { const int r0_ = ATT_ROW(t); rv = *(const u32x4*)(Vb + (size_t)(r0_ + kkey) * ldv + 8 * kc); } while (0)
#define ATT_STOREK(ks_) do { LAS unsigned char* kb_ = lds + (ks_) * KT_BYTES; *(LAS u32x4*)(kb_ + kkey * KSTR + kc * 16) = rk; if (DQK == 96 && tid < 256) *(LAS u32x4*)(kb_ + rkey * KSTR + 128 + rc * 16) = rr; } while (0)
#define ATT_STOREV(vs_) do { *(LAS u32x4*)(lds + V_OFF + (vs_) * VI_BYTES + kkey * VROW + kc * 16) = rv; } while (0)
#define ATT_ACTIVE(t) (!(NA && (t) < nloc) || ((t) >= wst && (t) < wst + 8))
#define ATT_QK(P0, P1, ks_) do { const LAS unsigned char* kb_ = kfr + (ks_) * KT_BYTES; \
        _Pragma("unroll") for (int kh = 0; kh < 2; ++kh) { bf16x8 ka_[NK / 2], kb2_[NK / 2]; \
            _Pragma("unroll") for (int kk = 0; kk < NK / 2; ++kk) { ka_[kk] = *(const LAS bf16x8*)(kb_ + (kh * (NK / 2) + kk) * 32); kb2_[kk] = *(const LAS bf16x8*)(kb_ + 32 * KSTR + (kh * (NK / 2) + kk) * 32); } \
            _Pragma("unroll") for (int kk = 0; kk < NK / 2; ++kk) { \
                if (kh == 0 && kk == 0) { P0 = __builtin_amdgcn_mfma_f32_32x32x16_bf16(ka_[0], qf[0], negm, 0, 0, 0); P1 = __builtin_amdgcn_mfma_f32_32x32x16_bf16(kb2_[0], qf[0], negm, 0, 0, 0); } \
                else { P0 = __builtin_amdgcn_mfma_f32_32x32x16_bf16(ka_[kk], qf[kh * (NK / 2) + kk], P0, 0, 0, 0); P1 = __builtin_amdgcn_mfma_f32_32x32x16_bf16(kb2_[kk], qf[kh * (NK / 2) + kk], P1, 0, 0, 0); } } } } while (0)
#define ATT_STEP(PC0, PC1, PN0, PN1, t, HASN) do { \
        if (DBG != 2) { if ((t) + 2 < nt) ATT_LOADK((t) + 2); \
        if ((t) + 1 < nt) ATT_LOADV((t) + 1); } \
        const bool act_ = ATT_ACTIVE(t); \
        if (act_) { \
            if (NA && (t) < nloc) { const LAS float* brow = rpbL + (drow0 + (t)) * 31 + 15 - cq; \
                _Pragma("unroll") for (int r = 0; r < 16; ++r) { const int kc0 = 16 * (r >> 3) + 8 * h + (r & 7), kc1 = kc0 + 32; \
                    PC0[r] = ((unsigned)(kc0 - cs_) < 16u) ? PC0[r] + brow[kc0] : NEG; PC1[r] = ((unsigned)(kc1 - cs_) < 16u) ? PC1[r] + brow[kc1] : NEG; } } \
            float mx = 0.f; if (DBG != 1) { \
            float m0_ = fmaxf(fmaxf(PC0[0], PC0[1]), PC0[2]), m1_ = fmaxf(fmaxf(PC1[0], PC1[1]), PC1[2]); \
            _Pragma("unroll") for (int r = 3; r < 15; r += 2) { m0_ = fmaxf(fmaxf(m0_, PC0[r]), PC0[r + 1]); m1_ = fmaxf(fmaxf(m1_, PC1[r]), PC1[r + 1]); } \
            mx = fmaxf(fmaxf(m0_, PC0[15]), fmaxf(m1_, PC1[15])); \
            } \
            if (__any(mx > 8.f)) { mx = fmaxf(mx, __shfl_xor(mx, 32)); const float dl = fmaxf(mx, 0.f), al = fast_exp2(-dl); lsum *= al;     \
                _Pragma("unroll") for (int r = 0; r < 16; ++r) { o0[r] *= al; o1[r] *= al; PC0[r] -= dl; PC1[r] -= dl; negm[r] -= dl; } } \
        } \
        if (HASN) { if (ATT_ACTIVE((t) + 1)) ATT_QK(PN0, PN1, ((t) + 1) % 3); } \
        if (act_) { \
            const LAS unsigned char* vb_ = vfr + ((t) & 1) * VI_BYTES; \
            float sacc = 0.f; \
            if (DBG != 1) { _Pragma("unroll") for (int r = 0; r < 16; ++r) { PC0[r] = fast_exp2(PC0[r]); PC1[r] = fast_exp2(PC1[r]); sacc += PC0[r] + PC1[r]; } } \
            lsum += sacc; \
            bf16x8 pf[4]; \
            _Pragma("unroll") for (int ks = 0; ks < 2; ++ks) { u32x4 w, w2; \
                w.x = cvt_pk_bf16(PC0[8 * ks + 0], PC0[8 * ks + 1]); w.y = cvt_pk_bf16(PC0[8 * ks + 2], PC0[8 * ks + 3]); w.z = cvt_pk_bf16(PC0[8 * ks + 4], PC0[8 * ks + 5]); w.w = cvt_pk_bf16(PC0[8 * ks + 6], PC0[8 * ks + 7]); \
                w2.x = cvt_pk_bf16(PC1[8 * ks + 0], PC1[8 * ks + 1]); w2.y = cvt_pk_bf16(PC1[8 * ks + 2], PC1[8 * ks + 3]); w2.z = cvt_pk_bf16(PC1[8 * ks + 4], PC1[8 * ks + 5]); w2.w = cvt_pk_bf16(PC1[8 * ks + 6], PC1[8 * ks + 7]); \
                pf[ks] = __builtin_bit_cast(bf16x8, w); pf[2 + ks] = __builtin_bit_cast(bf16x8, w2); } \
            _Pragma("unroll") for (int vh = 0; vh < 2; ++vh) { bf16x8 va_[2], vb2_[2]; \
                _Pragma("unroll") for (int ks = 0; ks < 2; ++ks) { va_[ks] = vtr8(vb_ + (2 * vh + ks) * 16 * VROW); vb2_[ks] = vtr8(vb_ + (2 * vh + ks) * 16 * VROW + 64); } \
                _Pragma("unroll") for (int ks = 0; ks < 2; ++ks) { o0 = __builtin_amdgcn_mfma_f32_32x32x16_bf16(va_[ks], pf[2 * vh + ks], o0, 0, 0, 0); o1 = __builtin_amdgcn_mfma_f32_32x32x16_bf16(vb2_[ks], pf[2 * vh + ks], o1, 0, 0, 0); } } \
        } \
        if (DBG != 2) { if ((t) + 2 < nt) ATT_STOREK(((t) + 2) % 3); \
        if ((t) + 1 < nt) ATT_STOREV(((t) + 1) & 1); } \
        if (DBG != 3) __syncthreads(); \
    } while (0)
    f32x16 pA0, pA1, pB0, pB1;
    ATT_LOADK(0); ATT_LOADV(0); ATT_STOREK(0); ATT_STOREV(0);
    if (nt > 1) { ATT_LOADK(1); ATT_STOREK(1); }
    __syncthreads();
    pA0 = (f32x16){}; pA1 = (f32x16){}; pB0 = (f32x16){}; pB1 = (f32x16){};
    if (ATT_ACTIVE(0)) ATT_QK(pA0, pA1, 0);
    int t = 0;
    for (; t + 2 < nt; t += 2) { ATT_STEP(pA0, pA1, pB0, pB1, t, true); ATT_STEP(pB0, pB1, pA0, pA1, t + 1, true); }
    if (t + 2 == nt) { ATT_STEP(pA0, pA1, pB0, pB1, t, true); ATT_STEP(pB0, pB1, pA0, pA1, t + 1, false); }
    else { ATT_STEP(pA0, pA1, pB0, pB1, t, false); }
    lsum += __shfl_xor(lsum, 32);
    const float inv = 1.f / lsum;
    bf16* orow = Ow + (size_t)q * ldo;
#pragma unroll
    for (int g = 0; g < 4; ++g) {
        u32x2 w0, w1; w0.x = cvt_pk_bf16(o0[4 * g] * inv, o0[4 * g + 1] * inv); w0.y = cvt_pk_bf16(o0[4 * g + 2] * inv, o0[4 * g + 3] * inv);
        w1.x = cvt_pk_bf16(o1[4 * g] * inv, o1[4 * g + 1] * inv); w1.y = cvt_pk_bf16(o1[4 * g + 2] * inv, o1[4 * g + 3] * inv);
        *(u32x2*)(orow + 8 * g + 4 * h) = w0; *(u32x2*)(orow + 32 + 8 * g + 4 * h) = w1;
    }
#undef ATT_ROW
#undef ATT_LOADK
#undef ATT_LOADV
#undef ATT_STOREK
#undef ATT_STOREV
#undef ATT_ACTIVE
#undef ATT_QK
#undef ATT_STEP
}

struct NaCtx { int lo, nloc, wa, wb, rws, cs, kb0, qrow, qcol, pk, q, hh; };
__device__ __forceinline__ void na_compute(LAS unsigned char* lds, const NaCtx& c, int t, const bf16x8 (&qf)[4], f32x16& o0, f32x16& o1, f32x16& negm, float& lsum) {
    const LAS float* rpbL = (const LAS float*)(lds + RPB_OFF);
    const int q = c.q, hh = c.hh, pk = c.pk, kb0 = c.kb0;
    const LAS unsigned char* kb = lds + (t & 1) * (KT_BYTES + VI_BYTES);
    const LAS unsigned char* vb = kb + KT_BYTES + (8 * hh + ((q & 15) >> 2)) * VROW + (16 * ((q >> 4) & 1) + 4 * (q & 3)) * 2;
    if (t < c.nloc) {
        const int kr = c.lo + t;
        if (kr >= c.wa && kr < c.wb + 8) {
            const LAS unsigned char* kf = kb + (kb0 + pk) * KSTR + hh * 16; bf16x8 ka[4];
#pragma unroll
            for (int kk = 0; kk < 4; ++kk) ka[kk] = *(const LAS bf16x8*)(kf + kk * 32);
            f32x16 p0 = __builtin_amdgcn_mfma_f32_32x32x16_bf16(ka[0], qf[0], negm, 0, 0, 0);
#pragma unroll
            for (int kk = 1; kk < 4; ++kk) p0 = __builtin_amdgcn_mfma_f32_32x32x16_bf16(ka[kk], qf[kk], p0, 0, 0, 0);
            bf16x8 va[2], vb2[2];
#pragma unroll
            for (int ks = 0; ks < 2; ++ks) { va[ks] = vtr8(vb + (kb0 + 16 * ks) * VROW); vb2[ks] = vtr8(vb + (kb0 + 16 * ks) * VROW + 64); }
            const bool rok = (unsigned)(kr - c.rws) < 8u; const LAS float* brow = rpbL + (kr - c.qrow + 7) * 31 + 15 - c.qcol;
            float mx = NEG, bv[16];
#pragma unroll
            for (int r = 0; r < 16; ++r) bv[r] = brow[kb0 + 16 * (r >> 3) + 8 * hh + (r & 7)];
#pragma unroll
            for (int r = 0; r < 16; ++r) { const int kcol = kb0 + 16 * (r >> 3) + 8 * hh + (r & 7);
                p0[r] = (rok && (unsigned)(kcol - c.cs) < 16u) ? p0[r] + bv[r] : NEG; mx = fmaxf(mx, p0[r]); }
            if (__any(mx > 8.f)) { mx = fmaxf(mx, __shfl_xor(mx, 32)); const float dl = fmaxf(mx, 0.f), al = fast_exp2(-dl); lsum *= al;
#pragma unroll
                for (int r = 0; r < 16; ++r) { o0[r] *= al; o1[r] *= al; p0[r] -= dl; negm[r] -= dl; } }
            float sacc = 0.f;
#pragma unroll
            for (int r = 0; r < 16; ++r) { p0[r] = fast_exp2(p0[r]); sacc += p0[r]; }
            lsum += sacc;
#pragma unroll
            for (int ks = 0; ks < 2; ++ks) { u32x4 wv; wv.x = cvt_pk_bf16(p0[8 * ks + 0], p0[8 * ks + 1]); wv.y = cvt_pk_bf16(p0[8 * ks + 2], p0[8 * ks + 3]); wv.z = cvt_pk_bf16(p0[8 * ks + 4], p0[8 * ks + 5]); wv.w = cvt_pk_bf16(p0[8 * ks + 6], p0[8 * ks + 7]);
                const bf16x8 pf = __builtin_bit_cast(bf16x8, wv);
                o0 = __builtin_amdgcn_mfma_f32_32x32x16_bf16(va[ks], pf, o0, 0, 0, 0); o1 = __builtin_amdgcn_mfma_f32_32x32x16_bf16(vb2[ks], pf, o1, 0, 0, 0); }
        }
    } else {
        const LAS unsigned char* kf = kb + pk * KSTR + hh * 16; bf16x8 ka[4], kb2[4];
#pragma unroll
        for (int kk = 0; kk < 4; ++kk) { ka[kk] = *(const LAS bf16x8*)(kf + kk * 32); kb2[kk] = *(const LAS bf16x8*)(kf + 32 * KSTR + kk * 32); }
        f32x16 p0 = __builtin_amdgcn_mfma_f32_32x32x16_bf16(ka[0], qf[0], negm, 0, 0, 0), p1 = __builtin_amdgcn_mfma_f32_32x32x16_bf16(kb2[0], qf[0], negm, 0, 0, 0);
#pragma unroll
        for (int kk = 1; kk < 4; ++kk) { p0 = __builtin_amdgcn_mfma_f32_32x32x16_bf16(ka[kk], qf[kk], p0, 0, 0, 0); p1 = __builtin_amdgcn_mfma_f32_32x32x16_bf16(kb2[kk], qf[kk], p1, 0, 0, 0); }
        float mx = fmaxf(p0[0], p1[0]);
#pragma unroll
        for (int r = 1; r < 16; ++r) mx = fmaxf(mx, fmaxf(p0[r], p1[r]));
        if (__any(mx > 8.f)) { mx = fmaxf(mx, __shfl_xor(mx, 32)); const float dl = fmaxf(mx, 0.f), al = fast_exp2(-dl); lsum *= al;
#pragma unroll
            for (int r = 0; r < 16; ++r) { o0[r] *= al; o1[r] *= al; p0[r] -= dl; p1[r] -= dl; negm[r] -= dl; } }
        float sacc = 0.f;
#pragma unroll
        for (int r = 0; r < 16; ++r) { p0[r] = fast_exp2(p0[r]); p1[r] = fast_exp2(p1[r]); sacc += p0[r] + p1[r]; }
        lsum += sacc;
#pragma unroll
        for (int ks = 0; ks < 4; ++ks) { u32x4 wv;
            if (ks < 2) { wv.x = cvt_pk_bf16(p0[8 * ks + 0], p0[8 * ks + 1]); wv.y = cvt_pk_bf16(p0[8 * ks + 2], p0[8 * ks + 3]); wv.z = cvt_pk_bf16(p0[8 * ks + 4], p0[8 * ks + 5]); wv.w = cvt_pk_bf16(p0[8 * ks + 6], p0[8 * ks + 7]); }
            else { const int bb = 8 * (ks - 2); wv.x = cvt_pk_bf16(p1[bb + 0], p1[bb + 1]); wv.y = cvt_pk_bf16(p1[bb + 2], p1[bb + 3]); wv.z = cvt_pk_bf16(p1[bb + 4], p1[bb + 5]); wv.w = cvt_pk_bf16(p1[bb + 6], p1[bb + 7]); }
            const bf16x8 pf = __builtin_bit_cast(bf16x8, wv);
            const bf16x8 v0 = vtr8(vb + 16 * ks * VROW), v1 = vtr8(vb + 16 * ks * VROW + 64);
            o0 = __builtin_amdgcn_mfma_f32_32x32x16_bf16(v0, pf, o0, 0, 0, 0); o1 = __builtin_amdgcn_mfma_f32_32x32x16_bf16(v1, pf, o1, 0, 0, 0); }
    }
}
__device__ __forceinline__ void na_unit(LAS unsigned char* lds, const bf16* __restrict__ P, bf16* __restrict__ O, int b, int h, int r0) {
    int tid = threadIdx.x; asm volatile("" : "+v"(tid));
    const int lane = tid & 63, q = lane & 31, hh = lane >> 5, w = __builtin_amdgcn_readfirstlane(tid >> 6);
    constexpr int KS2 = 2 * (KT_BYTES + VI_BYTES);
    const int rq0 = r0 + 2 * (w >> 2), c0 = 16 * (w & 3), qrow = rq0 + (q >> 4), qcol = c0 + (q & 15);
    NaCtx c; c.q = q; c.hh = hh; c.qrow = qrow; c.qcol = qcol;
    c.kb0 = c0 - 8 < 0 ? 0 : (c0 - 8 > 32 ? 32 : c0 - 8);
    int lo = r0 - 4; lo = lo < 0 ? 0 : (lo > 120 ? 120 : lo); int hs = r0 - 1; hs = hs < 0 ? 0 : (hs > 120 ? 120 : hs); const int nloc = hs + 7 - lo + 1, nt = nloc + 4; c.lo = lo; c.nloc = nloc;
    int wa = rq0 - 4; wa = wa < 0 ? 0 : (wa > 120 ? 120 : wa); int wb = rq0 - 3; wb = wb < 0 ? 0 : (wb > 120 ? 120 : wb); c.wa = wa; c.wb = wb;
    int rws = qrow - 4; rws = rws < 0 ? 0 : (rws > 120 ? 120 : rws); int cs = qcol - 8; cs = cs < 0 ? 0 : (cs > 48 ? 48 : cs); c.rws = rws; c.cs = cs;
    c.pk = (q & 3) | (((q >> 3) & 1) << 2) | (((q >> 2) & 1) << 3) | (q & 16);
    const size_t qg = (size_t)(b * SEQ + qrow * 64 + qcol);
    bf16x8 qf[4];
#pragma unroll
    for (int kk = 0; kk < 4; ++kk) qf[kk] = *(const bf16x8*)(P + qg * NPROJ + C_QA + h * 64 + kk * 16 + hh * 8);
    const bf16* Kb = P + C_KA + h * 64; const bf16* Vb = P + C_VA + h * 64;
    const int kkey = tid >> 3, kc = tid & 7, vkey = tid & 63, vc = tid >> 6;
    float lsum = 0.f; f32x16 o0 = {}, o1 = {}; f32x16 negm = {};
    u32x4 rkA, rvA, rkB, rvB, rkC, rvC;
#define NA_ROW(t) (((t) < nloc) ? b * SEQ + (lo + (t)) * 64 : TL + b * CTXL + 64 * ((t) - nloc))
#define NA_LOAD(t, RK, RV) do { const int r0_ = NA_ROW(t); RK = *(const u32x4*)(Kb + (size_t)(r0_ + kkey) * NPROJ + 8 * kc); RV = *(const u32x4*)(Vb + (size_t)(r0_ + kkey) * NPROJ + 8 * kc); } while (0)
#define NA_STORE(s_, RK, RV) do { LAS unsigned char* kb_ = lds + (s_) * (KT_BYTES + VI_BYTES); *(LAS u32x4*)(kb_ + kkey * KSTR + kc * 16) = RK; *(LAS u32x4*)(kb_ + KT_BYTES + kkey * VROW + kc * 16) = RV; } while (0)
#define NA_STEP(t, LK, LV, SK, SV) do { { const int tl_ = (t) + 3 < nt ? (t) + 3 : nt - 1; NA_LOAD(tl_, LK, LV); } if ((t) < nt) na_compute(lds, c, (t), qf, o0, o1, negm, lsum); NA_STORE(((t) + 1) & 1, SK, SV); __syncthreads(); } while (0)
    static_assert(KS2 <= RPB_OFF, "two stages below the rpb table");
    NA_LOAD(0, rkA, rvA); NA_LOAD(1, rkB, rvB); NA_LOAD(2, rkC, rvC);
    NA_STORE(0, rkA, rvA); __syncthreads();
    for (int t = 0; t < nt; t += 3) {
        NA_STEP(t, rkA, rvA, rkB, rvB);
        NA_STEP(t + 1, rkB, rvB, rkC, rvC);
        NA_STEP(t + 2, rkC, rvC, rkA, rvA);
    }
    lsum += __shfl_xor(lsum, 32);
    const float inv = 1.f / lsum;
    bf16* orow = O + qg * 2048 + h * 64;
#pragma unroll
    for (int g = 0; g < 4; ++g) {
        u32x2 w0, w1; w0.x = cvt_pk_bf16(o0[4 * g] * inv, o0[4 * g + 1] * inv); w0.y = cvt_pk_bf16(o0[4 * g + 2] * inv, o0[4 * g + 3] * inv);
        w1.x = cvt_pk_bf16(o1[4 * g] * inv, o1[4 * g + 1] * inv); w1.y = cvt_pk_bf16(o1[4 * g + 2] * inv, o1[4 * g + 3] * inv);
        *(u32x2*)(orow + 8 * g + 4 * hh) = w0; *(u32x2*)(orow + 32 + 8 * g + 4 * hh) = w1;
    }
#undef NA_ROW
#undef NA_LOAD
#undef NA_STORE
#undef NA_STEP
}
}

#define XB_TMO      128
#define XB_XCNT(j)  (256  + 64 * (j))
#define XB_XSUB(j)  (1280 + 64 * (j))
#define XB_XGEN(j)  (2304 + 64 * (j))
#define XB_TOP      3328
#define XB_TOPGEN   3392
#define XCD_BAR_WORDS 3456
#define XB_SPIN_CAP (1u << 22)
__device__ __forceinline__ unsigned xb_ld(unsigned* p)              { return __hip_atomic_load(p, __ATOMIC_RELAXED, __HIP_MEMORY_SCOPE_AGENT); }
__device__ __forceinline__ unsigned xb_add(unsigned* p, unsigned v) { return __hip_atomic_fetch_add(p, v, __ATOMIC_RELAXED, __HIP_MEMORY_SCOPE_AGENT); }
__device__ __forceinline__ unsigned xb_xcc_id() { return (unsigned)__builtin_amdgcn_s_getreg((3 << 11) | 20) & 0xFu; }
#define XB_SPIN(cond, bar) do { unsigned _sp = 0; while (cond) { __builtin_amdgcn_s_sleep(1); \
    if ((++_sp & 255u) == 0u) { if (xb_ld(&(bar)[XB_TMO])) break; if (_sp > XB_SPIN_CAP) { atomicAdd(&(bar)[XB_TMO], 1u); break; } } } } while (0)
struct XcdBarrier { unsigned* bar; unsigned x; volatile LAS unsigned* st; };
__device__ __forceinline__ XcdBarrier xcd_barrier_post(unsigned* bar, volatile LAS unsigned* st) {
    XcdBarrier b; b.bar = bar; b.x = xb_xcc_id(); b.st = st;
    if (threadIdx.x == 0) (void)xb_add(&bar[XB_XCNT(b.x)], 1u);
    return b;
}
__device__ __forceinline__ void xcd_barrier_complete(unsigned* bar, unsigned x, unsigned& nloc, unsigned& nx) {
    const unsigned G = gridDim.x * gridDim.y * gridDim.z;
    unsigned sum, cnt, mine, sp = 0u;
    for (;;) {
        sum = 0u; cnt = 0u; mine = 0u;
#pragma unroll
        for (unsigned j = 0; j < 16; ++j) { const unsigned c = xb_ld(&bar[XB_XCNT(j)]); sum += c; cnt += (c > 0u) ? 1u : 0u; mine = (j == x) ? c : mine; }
        if (sum == G) break;
        __builtin_amdgcn_s_sleep(1);
        if ((++sp & 255u) == 0u) { if (xb_ld(&bar[XB_TMO])) break; if (sp > XB_SPIN_CAP) { atomicAdd(&bar[XB_TMO], 1u); break; } }
    }
    nloc = mine > 0u ? mine : 1u; nx = cnt > 0u ? cnt : 1u;
}
__device__ __forceinline__ void xcd_barrier(const XcdBarrier& b) {
    asm volatile("s_waitcnt vmcnt(0)" ::: "memory");
    __syncthreads();
    if (threadIdx.x == 0) {
        unsigned* bar = b.bar;
        __builtin_amdgcn_s_waitcnt(0);
        unsigned nloc = b.st[0], nx = b.st[1];
        if (nloc == 0u) { xcd_barrier_complete(bar, b.x, nloc, nx); b.st[0] = nloc; b.st[1] = nx; }
        const unsigned old = xb_add(&bar[XB_XSUB(b.x)], 1u);
        const unsigned gen = old / nloc;
        if (old + 1u == (gen + 1u) * nloc) {
            __builtin_amdgcn_fence(__ATOMIC_RELEASE, "agent");
            asm volatile("s_waitcnt vmcnt(0)" ::: "memory");
            const unsigned og = xb_add(&bar[XB_TOP], 1u);
            const unsigned tg = og / nx;
            if (og + 1u == (tg + 1u) * nx) xb_add(&bar[XB_TOPGEN], 1u);
            else XB_SPIN(xb_ld(&bar[XB_TOPGEN]) == tg, bar);
            __builtin_amdgcn_fence(__ATOMIC_ACQUIRE, "agent");
            xb_add(&bar[XB_XGEN(b.x)], 1u);
            asm volatile("s_waitcnt vmcnt(0)" ::: "memory");
        } else {
            XB_SPIN(xb_ld(&bar[XB_XGEN(b.x)]) == gen, bar);
            __builtin_amdgcn_fence(__ATOMIC_ACQUIRE, "agent");
            asm volatile("s_waitcnt vmcnt(0)" ::: "memory");
        }
    }
    __syncthreads();
}

struct Args {
    const float *x, *c, *ctx, *c_ctx, *w_ada, *b_ada, *g_norm, *w_in, *na_rpb, *pool_w, *pool_scale, *mla_g_q, *mla_w_uq, *mla_g_kv, *mla_w_ukv, *conv_w, *w_branch, *w_out,
                *ffn_w1, *ffn_w3, *ffn_w2, *moe_router, *moe_w1, *moe_w3, *moe_w2;
    float* out; unsigned char* ws; int rep; int pad;
};
struct Frame { LAS unsigned char* lds; int tid, lane, wave, G, gw, NGW; };
#define CAS __attribute__((address_space(4)))
typedef const CAS Args* ArgP;
__device__ __forceinline__ ArgP kargs() { ArgP p = (ArgP)__builtin_amdgcn_kernarg_segment_ptr(); asm volatile("" : "+s"(p)); return p; }
__device__ __forceinline__ Frame make_frame() {
    extern __shared__ __attribute__((aligned(16))) unsigned char lds_raw[];
    Frame F; F.lds = (LAS unsigned char*)lds_raw; int t = threadIdx.x; asm volatile("" : "+v"(t)); F.tid = t; F.lane = t & 63; F.wave = __builtin_amdgcn_readfirstlane(t >> 6); F.G = gridDim.x;
    F.gw = blockIdx.x * 8 + F.wave; F.NGW = F.G * 8; return F;
}

__device__ __forceinline__ void xpose_item(const float* __restrict__ W, int ldw, int scol, const float* __restrict__ ksc, int k0, bf16* WT, int ldt, int drow, LAS float* scr, int lane) {
    if (scol >= 0) {
        float v[32];
#pragma unroll
        for (int i = 0; i < 32; ++i) { const int kk = 2 * i + (lane >> 5); v[i] = W[(size_t)(k0 + kk) * ldw + scol + (lane & 31)]; }
        if (ksc) {
#pragma unroll
            for (int i = 0; i < 32; ++i) { const int kk = 2 * i + (lane >> 5); v[i] *= ksc[k0 + kk]; } }
#pragma unroll
        for (int i = 0; i < 32; ++i) { const int kk = 2 * i + (lane >> 5); scr[kk * 33 + (lane & 31)] = v[i]; }
    } else {
#pragma unroll 8
        for (int i = 0; i < 32; ++i) { const int kk = 2 * i + (lane >> 5); scr[kk * 33 + (lane & 31)] = 0.f; }
    }
    LDS_WAIT(); asm volatile("" ::: "memory");
    const int c = lane & 7;
#pragma unroll
    for (int j = 0; j < 4; ++j) { const int n = (lane >> 3) + 8 * j; const LAS float* s = scr + (8 * c) * 33 + n;
        u32x4 o; o.x = pk2(s[0 * 33], s[1 * 33]); o.y = pk2(s[2 * 33], s[3 * 33]); o.z = pk2(s[4 * 33], s[5 * 33]); o.w = pk2(s[6 * 33], s[7 * 33]);
        *(u32x4*)(WT + (size_t)(drow + n) * ldt + k0 + 8 * c) = o; }
    LDS_WAIT(); asm volatile("" ::: "memory");
}
__device__ __forceinline__ void xpose_item_f8(const float* __restrict__ W, int ldw, int scol, float scale, int k0, unsigned char* WT, int ldt, int drow, LAS float* scr, int lane) {
    if (scol >= 0) {
        float v[32];
#pragma unroll
        for (int i = 0; i < 32; ++i) { const int kk = 2 * i + (lane >> 5); v[i] = W[(size_t)(k0 + kk) * ldw + scol + (lane & 31)]; }
#pragma unroll
        for (int i = 0; i < 32; ++i) { const int kk = 2 * i + (lane >> 5); scr[kk * 33 + (lane & 31)] = v[i] * scale; }
    } else {
#pragma unroll 8
        for (int i = 0; i < 32; ++i) { const int kk = 2 * i + (lane >> 5); scr[kk * 33 + (lane & 31)] = 0.f; }
    }
    LDS_WAIT(); asm volatile("" ::: "memory");
    const int c = lane & 7;
#pragma unroll
    for (int j = 0; j < 4; ++j) { const int n = (lane >> 3) + 8 * j; const LAS float* q = scr + (8 * c) * 33 + n;
        u32x2 o; o.x = pk4_fp8(q[0 * 33], q[1 * 33], q[2 * 33], q[3 * 33]); o.y = pk4_fp8(q[4 * 33], q[5 * 33], q[6 * 33], q[7 * 33]);
        *(u32x2*)(WT + (size_t)(drow + n) * ldt + k0 + 8 * c) = o; }
    LDS_WAIT(); asm volatile("" ::: "memory");
}
__host__ __device__ __forceinline__ bool win_tile_f8(int pn) { return pn < 6 || pn >= 14; }
__device__ __forceinline__ int win_src_col(int n) { return n < 2048 ? n : (n < 7680 ? n + 672 : (n < 8352 ? n - 7680 + 2048 : -1)); }

__device__ __forceinline__ void phase_prologue() {
    ArgP a = kargs(); Frame F = make_frame();
    unsigned char* ws = a->ws;
    LAS float* scr = (LAS float*)(F.lds + F.wave * 16384);
    constexpr int I_WIN = 16 * (NPROJ / 32), I_WUQ = 6 * 24, I_WUKV = 4 * 32, I_WBR = 4 * 8 * 32, I_WOUT = 16 * 32, I_L = I_WIN + I_WUQ + I_WUKV + I_WBR + I_WOUT;
    constexpr int I_F13 = 16 * (2 * DFF / 32), I_F2 = (DFF / 64) * 32, NITEMS = 2 * I_L + I_F13 + I_F2;
    for (int it = F.gw; it < NITEMS; it += F.NGW) {
        int r = it;
        if (r < 2 * I_L) { const int l = r / I_L; r -= l * I_L; unsigned char* wl = ws + WS_WOTHER + l * WL_SIZE;
            if (r < I_WIN) { const int nb = r % (NPROJ / 32), kb = r / (NPROJ / 32);
                if (win_tile_f8((nb * 32) >> 8))
                    xpose_item_f8(a->w_in + (size_t)l * 1024 * NREF, NREF, win_src_col(nb * 32), W13_SCALE, kb * 64, wl + WL_WIN + (size_t)((nb * 32) >> 8) * (256 * 2048), 1024, (nb * 32) & 255, scr, F.lane);
                else xpose_item(a->w_in + (size_t)l * 1024 * NREF, NREF, win_src_col(nb * 32), nullptr, kb * 64, (bf16*)(wl + WL_WIN), 1024, nb * 32, scr, F.lane);
                continue; } r -= I_WIN;
            if (r < I_WUQ) { const int nb = r % 24, kb = r / 24; xpose_item(a->mla_w_uq + (size_t)l * 384 * 768, 768, nb * 32, a->mla_g_q + l * 384, kb * 64, (bf16*)(wl + WL_WUQ), 384, nb * 32, scr, F.lane); continue; } r -= I_WUQ;
            if (r < I_WUKV) { const int nb = r % 32, kb = r / 32; xpose_item(a->mla_w_ukv + (size_t)l * 256 * 1024, 1024, nb * 32, a->mla_g_kv + l * 256, kb * 64, (bf16*)(wl + WL_WUKV), 256, nb * 32, scr, F.lane); continue; } r -= I_WUKV;
            if (r < I_WBR) { const int k = r / 256, rr = r % 256, nb = rr % 32, kb = rr / 32; xpose_item(a->w_branch + ((size_t)l * 4 + k) * 512 * 1024, 1024, nb * 32, nullptr, kb * 64, (k == 1) ? (bf16*)(ws + WS_E) + (size_t)l * 1024 * 512 : (bf16*)(wl + WL_WBR) + k * 512, (k == 1) ? 512 : 2048, nb * 32, scr, F.lane); continue; } r -= I_WBR;
            { const int nb = r % 32, kb = r / 32; xpose_item(a->w_out + (size_t)l * 1024 * 1024, 1024, nb * 32, nullptr, kb * 64, (bf16*)(wl + WL_WOUT), 1024, nb * 32, scr, F.lane); continue; }
        }
        r -= 2 * I_L;
        if (r < I_F13) { const int nb = r % (2 * DFF / 32), kb = r / (2 * DFF / 32); const int n0 = nb * 32, tile = n0 >> 8, w = n0 & 255;
            const float* src = (w < 128) ? a->ffn_w1 : a->ffn_w3; xpose_item(src, DFF, tile * 128 + (w & 127), nullptr, kb * 64, (bf16*)(ws + WS_WOTHER + WO_F13), 1024, n0, scr, F.lane); continue; }
        r -= I_F13;
        { const int nb = r % 32, kb = r / 32; xpose_item(a->ffn_w2, 1024, nb * 32, nullptr, kb * 64, (bf16*)(ws + WS_WOTHER + WO_F2), DFF, nb * 32, scr, F.lane); }
    }
    { const float* pw = a->pool_w; const float* psc = a->pool_scale;
      for (int idx = F.gw * 64 + F.lane; idx < 2 * 512 * 512; idx += F.NGW * 64) { const int l = idx >> 18, c = (idx >> 9) & 511, j = idx & 511, g = c >> 7;
        const float v = ((j >> 7) == g) ? pw[(((size_t)l * 4 + g) * 128 + (c & 127)) * 128 + (j & 127)] * psc[l * 512 + j] : 0.f;
        ((bf16*)(ws + WS_WOTHER + l * WL_SIZE + WL_WPOOL))[c * 512 + j] = (bf16)f2bf(v); } }
    if (blockIdx.x == 0) { float* ct = (float*)(ws + WS_ROPE); float* st = ct + 1024;
        for (int i = F.tid; i < 1024; i += 512) { const int p = i >> 3, j = i & 7; const float inv = powf(10000.f, -(float)j / 8.f); const float ang = (float)p * inv; ct[i] = (float)cos((double)ang); st[i] = (float)sin((double)ang); } }
    __syncthreads();
    {
        LAS float* sc = (LAS float*)F.lds;
        LAS float* red = sc + 3 * 1024;
        const float* cc = a->c; const float* cx = a->c_ctx; const float* wada = a->w_ada; const float* bada = a->b_ada;
        for (int i = F.tid; i < 3 * 1024; i += 512) { const int v = i >> 10, k = i & 1023; const float cvv = (v < 2) ? cc[v * 1024 + k] : cx[k]; sc[i] = cvv / (1.f + expf(-cvv)); }
        __syncthreads();
        for (int cb = blockIdx.x; cb < 2 * 6144 / 64; cb += F.G) { const int l = cb / 96, n = (cb % 96) * 64 + (F.tid & 63), kg = F.tid >> 6;
            const float* w = wada + ((size_t)l * 1024 + kg * 128) * 6144 + n; float a0 = 0.f, a1 = 0.f, a2 = 0.f;
            for (int kb = 0; kb < 128; kb += 32) { float wv[32];
#pragma unroll
                for (int k = 0; k < 32; ++k) wv[k] = w[(size_t)(kb + k) * 6144];
#pragma unroll
                for (int k = 0; k < 32; ++k) { a0 += sc[kg * 128 + kb + k] * wv[k]; a1 += sc[1024 + kg * 128 + kb + k] * wv[k]; a2 += sc[2048 + kg * 128 + kb + k] * wv[k]; } }
            red[(kg * 3 + 0) * 64 + (F.tid & 63)] = a0; red[(kg * 3 + 1) * 64 + (F.tid & 63)] = a1; red[(kg * 3 + 2) * 64 + (F.tid & 63)] = a2;
            __syncthreads();
            if (F.tid < 192) { const int v = F.tid >> 6, j = F.tid & 63; float s = bada[l * 6144 + (cb % 96) * 64 + j];
#pragma unroll
                for (int g = 0; g < 8; ++g) s += red[(g * 3 + v) * 64 + j];
                ((float*)(ws + WS_MOD))[((size_t)l * 3 + v) * 6144 + (cb % 96) * 64 + j] = s; }
            __syncthreads();
        }
    }
}

__device__ __forceinline__ void moe_convert() {
    ArgP a = kargs(); Frame F = make_frame(); unsigned char* ws = a->ws;
    const float* w1 = a->moe_w1; const float* w3 = a->moe_w3; const float* w2 = a->moe_w2;
    LAS float* scr = (LAS float*)(F.lds + 32768 + F.wave * 8704);
    constexpr int I13 = 16 * (2 * DFE / 32), I2 = (DFE / 64) * 32, IE = I13 + I2;
    for (int it = F.gw; it < NEXP * IE; it += F.NGW) { const int e = it / IE; int r = it % IE;
        if (r < I13) { const int nb = r % (2 * DFE / 32), kb = r / (2 * DFE / 32); const int n0 = nb * 32, tile = n0 >> 8, w = n0 & 255;
            const float* src = ((w < 128) ? w1 : w3) + (size_t)e * 1024 * DFE;
            xpose_item_f8(src, DFE, tile * 128 + (w & 127), W13_SCALE, kb * 64, ws + WS_WMOE13 + (size_t)e * 7168 * 1024, 1024, n0, scr, F.lane); }
        else { r -= I13; const int nb = r % 32, kb = r / 32; xpose_item_f8(w2 + (size_t)e * DFE * 1024, 1024, nb * 32, W2_SCALE, kb * 64, ws + WS_WMOE2 + (size_t)e * 1024 * DFE, DFE, nb * 32, scr, F.lane); }
    }
}

__device__ __forceinline__ const float* modp(const unsigned char* ws, int l, int row, int j) { const int v = row < TL ? (row >> 13) : 2; return (const float*)(ws + WS_MOD) + (((size_t)l * 3 + v) * 6 + j) * 1024; }

__device__ __forceinline__ void moe_panel_starts(const unsigned char* ws, int (&pst)[NEXP], int& npan) {
    unsigned* cnt = (unsigned*)(ws + WS_CTL) + CW_CNT; int acc = 0;
#pragma unroll
    for (int e = 0; e < NEXP; ++e) { pst[e] = acc; acc += (int)((__hip_atomic_load(cnt + e * 64, RLX_AGENT) + 255u) >> 8); }
    npan = acc < MAXPAN ? acc : MAXPAN;
}
struct ColVec { f32x4 v[4]; };
__device__ __forceinline__ void colvec_load(ColVec& c, const float* p, int lane) {
#pragma unroll
    for (int j = 0; j < 4; ++j) c.v[j] = *(const f32x4*)(p + 4 * lane + 256 * j);
}
template <bool F8COPY = false>
__device__ __forceinline__ void norm_mod_store(const f32x4 (&xv)[4], const ColVec& g, const ColVec& shift, const ColVec& scale, bf16* orow, int lane, f32x4 (&tv)[4], unsigned char* o8row = nullptr) {
    float ss = 0.f;
#pragma unroll
    for (int j = 0; j < 4; ++j) ss += (xv[j].x * xv[j].x + xv[j].y * xv[j].y) + (xv[j].z * xv[j].z + xv[j].w * xv[j].w);
    const float r = rsqrtf(wave_sum(ss) * (1.f / 1024.f) + EPS);
#pragma unroll
    for (int j = 0; j < 4; ++j) { const int c = 4 * lane + 256 * j; const f32x4 gg = g.v[j], sh = shift.v[j], scl = scale.v[j];
        f32x4 t; t.x = (xv[j].x * r * gg.x) * (1.f + scl.x) + sh.x; t.y = (xv[j].y * r * gg.y) * (1.f + scl.y) + sh.y; t.z = (xv[j].z * r * gg.z) * (1.f + scl.z) + sh.z; t.w = (xv[j].w * r * gg.w) * (1.f + scl.w) + sh.w; tv[j] = t;
        u32x2 o; o.x = pk2(t.x, t.y); o.y = pk2(t.z, t.w); *(u32x2*)(orow + c) = o;
        if (F8COPY) *(unsigned*)(o8row + c) = pk4_fp8(t.x, t.y, t.z, t.w); }
}

struct SchedOne {
    int pm, pn; const char* A; const char* B; size_t tA, tB;
    __device__ __forceinline__ bool next(int i, Unit& u) const { u.pm = pm; u.pn = pn; u.aux = 0; return i == 0; }
    __device__ __forceinline__ void bases(const Unit& u, const char*& a, const char*& b) const { a = A + (size_t)u.pm * tA; b = B + (size_t)u.pn * tB; }
};
__device__ __forceinline__ void phase_norm_in() {
    ArgP a = kargs(); Frame F = make_frame(); unsigned char* ws = a->ws; const float* gn = a->g_norm; const float* xin = a->x; const float* cin = a->ctx;
    bf16* H = (bf16*)(ws + WS_C);
    const int nW = F.G >= 64 ? 16 : 0;
    for (int u = blockIdx.x; u < 16; u += (nW ? 16 : F.G)) { if (nW && (int)blockIdx.x >= 16) break;
        const int l = u >> 3, pm = (u >> 1) & 3, pn = u & 1; unsigned char* wl = ws + WS_WOTHER + (size_t)l * WL_SIZE;
        SchedOne S{pm, pn, (const char*)(ws + WS_E) + (size_t)l * 1024 * 512 * 2, (const char*)(wl + WL_WPOOL), (size_t)256 * 512 * 2, (size_t)256 * 512 * 2};
        EpiRowScale E{(bf16*)(wl + WL_WBR) + 512, 2048, nullptr, 0, 1.f};
        pg8::gemm_phase(F.lds, pg8::Gemm{512, 512, 512}, S, E); }
    if (nW && (int)blockIdx.x < 16) return;
    const int gw = nW ? ((int)blockIdx.x - 16) * 8 + F.wave : F.gw, ngw = nW ? (F.G - 16) * 8 : F.NGW;
    ColVec pg, psh, psc; colvec_load(pg, gn, F.lane); int curv = -1;
    for (int rowb = gw; rowb < T; rowb += 2 * ngw) {
        f32x4 xv[2][4], tv[4]; int rows[2];
#pragma unroll
        for (int q = 0; q < 2; ++q) { const int row = rowb + q * ngw; rows[q] = row; const int rl = row < T ? row : T - 1;
            const float* xr = rl < TL ? xin + (size_t)rl * 1024 : cin + (size_t)(rl - TL) * 1024;
#pragma unroll
            for (int j = 0; j < 4; ++j) xv[q][j] = *(const f32x4*)(xr + 4 * F.lane + 256 * j); }
#pragma unroll
        for (int q = 0; q < 2; ++q) if (rows[q] < T) { const int row = rows[q];
            const int v = row < TL ? (row >> 13) : 2; if (v != curv) { colvec_load(psh, modp(ws, 0, row, 0), F.lane); colvec_load(psc, modp(ws, 0, row, 1), F.lane); curv = v; }
            norm_mod_store<true>(xv[q], pg, psh, psc, H + (size_t)row * 1024, F.lane, tv, ws + WS_H8 + (size_t)row * 1024); } }
}

template <bool MOE, bool ROUTE, bool SRCIN, bool HAS2, bool F8OUT = false>
__device__ __forceinline__ void phase_resid(int nrows, size_t y_off, int l, int jgate, int ga_idx, int gb_idx, int lb, int jshift, size_t out_off) {
    ArgP a = kargs(); Frame F = make_frame(); unsigned char* ws = a->ws;
    const bf16* Y = (const bf16*)(ws + y_off); bf16* OUT = (bf16*)(ws + out_off);
    const float* gnorm = a->g_norm; const float* ga = gnorm + ga_idx * 1024; const float* gb = gnorm + gb_idx * 1024;
    float* xdst_lat = a->out; float* xdst_ctx = (float*)(ws + WS_XC);
    const float* xsrc_lat = SRCIN ? a->x : (const float*)xdst_lat; const float* xsrc_ctx = SRCIN ? a->ctx : (const float*)xdst_ctx;
    int moe_lim = 0; if (MOE) { int pst_[NEXP], npan_; moe_panel_starts(ws, pst_, npan_); moe_lim = (npan_ < 128 ? npan_ : 128) * 256; }
    const LAS float* rt = (const LAS float*)F.lds;
    if (ROUTE) { const float* mr = a->moe_router; for (int i = F.tid; i < 8192; i += 512) ((LAS float*)F.lds)[i] = mr[i]; __syncthreads(); }
    ColVec pga, pgb, pgt, psh, psc; colvec_load(pga, ga, F.lane); if (HAS2) colvec_load(pgb, gb, F.lane); int curv = -1;
    constexpr int NR = ROUTE ? 1 : 2;
    const int it_n = ROUTE ? ((nrows / 64 - (int)blockIdx.x + F.G - 1) / F.G) * 8 : 0; unsigned cntw = 0u;
    for (int rowb = ROUTE ? 0 : F.gw, it = 0; ROUTE ? (it < it_n) : (rowb < nrows); rowb += NR * F.NGW, ++it) {
        if (ROUTE) rowb = ((int)blockIdx.x + (it >> 3) * F.G) * 64 + F.wave * 8 + (it & 7);
        f32x4 yv[NR][4], xv[NR][4], tv[NR][4]; bool ok[NR]; int rows[NR];
        if (MOE) {
            int sl[NR][2]; u32x2 yr[NR][2][4];
#pragma unroll
            for (int q = 0; q < NR; ++q) { const int row = rowb + q * F.NGW; rows[q] = row; ok[q] = row < nrows; const int rl = ok[q] ? row : nrows - 1;
                const int* t2s = (const int*)(ws + WS_TOK2SLOT) + rl * 2; sl[q][0] = t2s[0]; sl[q][1] = t2s[1]; }
#pragma unroll
            for (int q = 0; q < NR; ++q) { const int rl = ok[q] ? rows[q] : nrows - 1; const float* xr = rl < TL ? xsrc_lat + (size_t)rl * 1024 : xsrc_ctx + (size_t)(rl - TL) * 1024;
#pragma unroll
                for (int k = 0; k < 2; ++k) { const int sc_ = sl[q][k] < moe_lim ? sl[q][k] : moe_lim - 1;
#pragma unroll
                    for (int j = 0; j < 4; ++j) yr[q][k][j] = *(const u32x2*)(Y + (size_t)sc_ * 1024 + 4 * F.lane + 256 * j); }
#pragma unroll
                for (int j = 0; j < 4; ++j) xv[q][j] = *(const f32x4*)(xr + 4 * F.lane + 256 * j); }
#pragma unroll
            for (int q = 0; q < NR; ++q) {
#pragma unroll
                for (int j = 0; j < 4; ++j) yv[q][j] = (f32x4){0.f, 0.f, 0.f, 0.f};
#pragma unroll
                for (int k = 0; k < 2; ++k) {
                    if (sl[q][k] < moe_lim) {
#pragma unroll
                        for (int j = 0; j < 4; ++j) { const u32x2 u0 = yr[q][k][j]; yv[q][j] += (f32x4){bflo(u0.x), bfhi(u0.x), bflo(u0.y), bfhi(u0.y)}; }
                    } else { const float* sp = (const float*)(ws + WS_D) + (size_t)(sl[q][k] - moe_lim) * 1024 + 4 * F.lane;
#pragma unroll
                        for (int ks = 0; ks < 2; ++ks)
#pragma unroll
                            for (int j = 0; j < 4; ++j) yv[q][j] += *(const f32x4*)(sp + (size_t)ks * (8 * 256 * 1024) + 256 * j); } } }
        } else {
            u32x2 yr[NR][4];
#pragma unroll
            for (int q = 0; q < NR; ++q) { const int row = rowb + q * F.NGW; rows[q] = row; ok[q] = row < nrows; const int rl = ok[q] ? row : nrows - 1;
                const float* xr = rl < TL ? xsrc_lat + (size_t)rl * 1024 : xsrc_ctx + (size_t)(rl - TL) * 1024;
#pragma unroll
                for (int j = 0; j < 4; ++j) yr[q][j] = *(const u32x2*)(Y + (size_t)rl * 1024 + 4 * F.lane + 256 * j);
#pragma unroll
                for (int j = 0; j < 4; ++j) xv[q][j] = *(const f32x4*)(xr + 4 * F.lane + 256 * j); }
#pragma unroll
            for (int q = 0; q < NR; ++q)
#pragma unroll
                for (int j = 0; j < 4; ++j) { const u32x2 u0 = yr[q][j]; yv[q][j] = (f32x4){bflo(u0.x), bfhi(u0.x), bflo(u0.y), bfhi(u0.y)}; }
        }
#pragma unroll
        for (int q = 0; q < NR; ++q) if (ok[q]) { const int row = rows[q];
            float* xw = row < TL ? xdst_lat + (size_t)row * 1024 : xdst_ctx + (size_t)(row - TL) * 1024;
            float ss = 0.f;
#pragma unroll
            for (int j = 0; j < 4; ++j) ss += (yv[q][j].x * yv[q][j].x + yv[q][j].y * yv[q][j].y) + (yv[q][j].z * yv[q][j].z + yv[q][j].w * yv[q][j].w);
            const float r = rsqrtf(wave_sum(ss) * (1.f / 1024.f) + EPS);
            { const int v = row < TL ? (row >> 13) : 2; if (v != curv) { colvec_load(pgt, modp(ws, l, row, jgate), F.lane); if (HAS2) { colvec_load(psh, modp(ws, lb, row, jshift), F.lane); colvec_load(psc, modp(ws, lb, row, jshift + 1), F.lane); } curv = v; } }
#pragma unroll
            for (int j = 0; j < 4; ++j) { const int c = 4 * F.lane + 256 * j; const f32x4 gg = pga.v[j], gv = pgt.v[j];
                xv[q][j].x += gv.x * (yv[q][j].x * r * gg.x); xv[q][j].y += gv.y * (yv[q][j].y * r * gg.y); xv[q][j].z += gv.z * (yv[q][j].z * r * gg.z); xv[q][j].w += gv.w * (yv[q][j].w * r * gg.w);
                *(f32x4*)(xw + c) = xv[q][j]; }
            if (HAS2) {
                norm_mod_store<F8OUT>(xv[q], pgb, psh, psc, OUT + (size_t)row * 1024, F.lane, tv[q], ws + WS_H8 + (size_t)row * 1024);
                if (ROUTE) {
                    float lg[8];
#pragma unroll
                    for (int e = 0; e < 8; ++e) lg[e] = 0.f;
#pragma unroll
                    for (int j = 0; j < 4; ++j)
#pragma unroll
                        for (int i = 0; i < 4; ++i) { const int c = 4 * F.lane + 256 * j + i; const f32x4 r0 = *(const LAS f32x4*)(rt + c * 8), r1 = *(const LAS f32x4*)(rt + c * 8 + 4); const float tvv = tv[q][j][i];
                            lg[0] += tvv * r0.x; lg[1] += tvv * r0.y; lg[2] += tvv * r0.z; lg[3] += tvv * r0.w; lg[4] += tvv * r1.x; lg[5] += tvv * r1.y; lg[6] += tvv * r1.z; lg[7] += tvv * r1.w; }
#pragma unroll
                    for (int e = 0; e < 8; ++e) lg[e] = wave_sum(lg[e]);
                    int e0 = 0; float v0 = lg[0];
#pragma unroll
                    for (int e = 1; e < 8; ++e) if (lg[e] > v0) { v0 = lg[e]; e0 = e; }
                    int e1 = -1; float v1 = -INFINITY;
#pragma unroll
                    for (int e = 0; e < 8; ++e) if (e != e0 && lg[e] > v1) { v1 = lg[e]; e1 = e; }
                    cntw += (1u << (4 * e0)) + (1u << (4 * e1));
                    if (F.lane == 0) { const float w0 = 1.f / (1.f + expf(v1 - v0)), w1 = 1.f - w0;
                        int* ro = (int*)(ws + WS_ROUTE) + (size_t)row * 8; ro[0] = e0; ro[1] = e1; ((float*)ro)[4] = w0; ((float*)ro)[5] = w1; }
                }
            }
        }
        if (ROUTE && (it & 7) == 7) {
            LAS unsigned* wc = (LAS unsigned*)(F.lds + 32768);
            if (F.lane == 0) wc[F.wave] = cntw;
            cntw = 0u; __syncthreads();
            if (F.tid < NEXP) { unsigned sum = 0u;
#pragma unroll
                for (int w = 0; w < 8; ++w) sum += (wc[w] >> (4 * F.tid)) & 15u;
                const int blk = (int)blockIdx.x + (it >> 3) * F.G;
                ((int*)(ws + WS_BLKCNT))[blk * 8 + F.tid] = (int)sum; atomicAdd((unsigned*)(ws + WS_CTL) + CW_CNT + F.tid * 64, sum); }
            __syncthreads();
        }
    }
}

__device__ __forceinline__ void phase_prep(int l) {
    ArgP a = kargs(); Frame F = make_frame(); unsigned char* ws = a->ws;
    const bf16* P = (const bf16*)(ws + WS_PROJ); bf16* O = (bf16*)(ws + WS_O); float* RS = (float*)(ws + WS_RS); bf16* KR = (bf16*)(ws + WS_KR);
    const float* ct = (const float*)(ws + WS_ROPE); const float* st = ct + 1024; const float* cw = a->conv_w + l * 3 * 512; const int lane = F.lane;
    const int l48 = lane < 48 ? lane : 47, l32 = lane & 31, l16 = lane & 15, pw = 2 << (lane >> 4);
#define PREP_SEQ(row, latent, base, t, N) const bool latent = row < TL; int base, t, N; \
        if (latent) { base = row & ~(SEQ - 1); t = row & (SEQ - 1); N = SEQ; } else { const int rr_ = row - TL; base = TL + (rr_ & ~(CTXL - 1)); t = rr_ & (CTXL - 1); N = CTXL; }
    {   f32x4 cw0[3], cw1[3];
#pragma unroll
        for (int j = 0; j < 3; ++j) { cw0[j] = *(const f32x4*)(cw + j * 512 + 8 * lane); cw1[j] = *(const f32x4*)(cw + j * 512 + 8 * lane + 4); }
        struct RowA { u32x4 vq, vk, bg, cg[3], xc[3]; unsigned vr; float rc, rsn; };
        for (int rowb = F.gw; rowb < T; rowb += 2 * F.NGW) { RowA R[2];
#pragma unroll
            for (int q = 0; q < 2; ++q) { int row = rowb + q * F.NGW; row = row < T ? row : T - 1; PREP_SEQ(row, latent, base, t, N) (void)latent;
                const bf16* pr = P + (size_t)row * NPROJ; RowA& r = R[q];
                r.vq = *(const u32x4*)(pr + C_CQ + 8 * l48); r.vk = *(const u32x4*)(pr + C_CKV + 8 * l32); r.vr = *(const unsigned*)(pr + C_KR + 2 * l16); r.bg = *(const u32x4*)(pr + C_BG + 8 * lane);
                const int pos = (l16 < 8) ? (t >> 6) : (t & 63); r.rc = ct[pos * 8 + (l16 & 7)]; r.rsn = st[pos * 8 + (l16 & 7)];
#pragma unroll
                for (int j = 0; j < 3; ++j) { int rr = t + j - 1; rr = rr < 0 ? 0 : (rr < N ? rr : N - 1); const bf16* qp = P + (size_t)(base + rr) * NPROJ; r.cg[j] = *(const u32x4*)(qp + C_CG + 8 * lane); r.xc[j] = *(const u32x4*)(qp + C_XC + 8 * lane); } }
#pragma unroll
            for (int q = 0; q < 2; ++q) { int row = rowb + q * F.NGW; row = row < T ? row : T - 1; PREP_SEQ(row, latent, base, t, N) (void)base; const RowA& r = R[q];
                float sq = 0.f, sk = 0.f;
                { const float f[8] = {bflo(r.vq.x), bfhi(r.vq.x), bflo(r.vq.y), bfhi(r.vq.y), bflo(r.vq.z), bfhi(r.vq.z), bflo(r.vq.w), bfhi(r.vq.w)};
#pragma unroll
                  for (int i = 0; i < 8; ++i) sq += f[i] * f[i];
                  sq = lane < 48 ? sq : 0.f; }
                { const float f[8] = {bflo(r.vk.x), bfhi(r.vk.x), bflo(r.vk.y), bfhi(r.vk.y), bflo(r.vk.z), bfhi(r.vk.z), bflo(r.vk.w), bfhi(r.vk.w)};
#pragma unroll
                  for (int i = 0; i < 8; ++i) sk += f[i] * f[i];
                  sk = lane < 32 ? sk : 0.f; }
                sq = wave_sum(sq); sk = wave_sum(sk);
                if (lane == 0) { RS[(size_t)row * 2] = rsqrtf(sq * (1.f / 384.f) + EPS); RS[(size_t)row * 2 + 1] = rsqrtf(sk * (1.f / 256.f) + EPS); }
                if (lane < 16) { float x0 = bflo(r.vr), x1 = bfhi(r.vr);
                    if (latent) { const float y0 = x0 * r.rc - x1 * r.rsn, y1 = x0 * r.rsn + x1 * r.rc; x0 = y0; x1 = y1; }
                    *(unsigned*)(KR + (size_t)row * 32 + 2 * lane) = pk2(x0, x1); }
                float acc[8];
#pragma unroll
                for (int i = 0; i < 8; ++i) acc[i] = 0.f;
#pragma unroll
                for (int j = 0; j < 3; ++j) { const int rr = t + j - 1; const float mk = (rr >= 0 && rr < N) ? 1.f : 0.f; const f32x4 w0 = cw0[j] * mk, w1 = cw1[j] * mk; const u32x4 c = r.cg[j], x = r.xc[j];
                    acc[0] += w0.x * bflo(c.x) * bflo(x.x); acc[1] += w0.y * bfhi(c.x) * bfhi(x.x); acc[2] += w0.z * bflo(c.y) * bflo(x.y); acc[3] += w0.w * bfhi(c.y) * bfhi(x.y);
                    acc[4] += w1.x * bflo(c.z) * bflo(x.z); acc[5] += w1.y * bfhi(c.z) * bfhi(x.z); acc[6] += w1.z * bflo(c.w) * bflo(x.w); acc[7] += w1.w * bfhi(c.w) * bfhi(x.w); }
                const u32x4 bg = r.bg;
                u32x4 o; o.x = pk2(acc[0] * bflo(bg.x), acc[1] * bfhi(bg.x)); o.y = pk2(acc[2] * bflo(bg.y), acc[3] * bfhi(bg.y)); o.z = pk2(acc[4] * bflo(bg.z), acc[5] * bfhi(bg.z)); o.w = pk2(acc[6] * bflo(bg.w), acc[7] * bfhi(bg.w));
                *(u32x4*)(O + (size_t)row * 2048 + 1536 + 8 * lane) = o; }
        }
    }
    {
        static_assert(T % 3 == 0, "row triples");
        for (int blk = F.gw; blk < T / 3; blk += F.NGW) { const int r0 = 3 * blk; u32x4 pv[19];
#pragma unroll
            for (int i = 0; i < 19; ++i) { int g = r0 - 8 + i; g = g < 0 ? 0 : (g < T ? g : T - 1); pv[i] = *(const u32x4*)(P + (size_t)g * NPROJ + C_UP + 8 * lane); }
#pragma unroll
            for (int q = 0; q < 3; ++q) { const int row = r0 + q; PREP_SEQ(row, latent, base, t, N) (void)latent;
                int lo = t - (pw >> 1), hi = lo + pw; lo = lo < 0 ? 0 : lo; hi = hi > N ? N : hi; const int glo = base + lo, ghi = base + hi;
                float acc[8];
#pragma unroll
                for (int i = 0; i < 8; ++i) acc[i] = 0.f;
#pragma unroll
                for (int i = 0; i < 19; ++i) { const int g = r0 - 8 + i; const u32x4 v = pv[i]; const float mk = (g >= glo && g < ghi) ? 1.f : 0.f;
                    acc[0] += mk * bflo(v.x); acc[1] += mk * bfhi(v.x); acc[2] += mk * bflo(v.y); acc[3] += mk * bfhi(v.y); acc[4] += mk * bflo(v.z); acc[5] += mk * bfhi(v.z); acc[6] += mk * bflo(v.w); acc[7] += mk * bfhi(v.w); }
                const float ic = 1.f / (float)(hi - lo); const u32x4 s_ = pv[8 + q];
                u32x4 o; o.x = pk2(acc[0] * ic - bflo(s_.x), acc[1] * ic - bfhi(s_.x)); o.y = pk2(acc[2] * ic - bflo(s_.y), acc[3] * ic - bfhi(s_.y));
                o.z = pk2(acc[4] * ic - bflo(s_.z), acc[5] * ic - bfhi(s_.z)); o.w = pk2(acc[6] * ic - bflo(s_.w), acc[7] * ic - bfhi(s_.w));
                *(u32x4*)(O + (size_t)row * 2048 + 512 + 8 * lane) = o; }
        }
    }
#undef PREP_SEQ
}

__device__ __forceinline__ void phase_moe_gather() {
    ArgP a = kargs(); Frame F = make_frame(); unsigned char* ws = a->ws;
    int pst[NEXP], npan; moe_panel_starts(ws, pst, npan);
    const bf16* TI = (const bf16*)(ws + WS_C); unsigned char* TP = ws + WS_E;   float* SW = (float*)(ws + WS_SLOTW); int* T2S = (int*)(ws + WS_TOK2SLOT); const int* BLK = (const int*)(ws + WS_BLKCNT);
    LAS int* pre = (LAS int*)F.lds;
    LAS int* slots = pre + 16;
    for (int blk = blockIdx.x; blk < TL / 64; blk += F.G) {
        u32x4 rv0[8], rv1[8];
#pragma unroll
        for (int i = 0; i < 8; ++i) { const int row = blk * 64 + F.wave * 8 + i; rv0[i] = *(const u32x4*)(TI + (size_t)row * 1024 + 8 * F.lane); rv1[i] = *(const u32x4*)(TI + (size_t)row * 1024 + 512 + 8 * F.lane); }
        if (F.tid < 16) pre[F.tid] = 0;
        __syncthreads();
        for (int idx = F.tid; idx < blk * 8; idx += 512) __hip_atomic_fetch_add(&pre[idx & 7], BLK[idx], __ATOMIC_RELAXED, __HIP_MEMORY_SCOPE_WORKGROUP);
        __syncthreads();
        if (F.wave == 0) { const int row = blk * 64 + F.lane; const int* ro = (const int*)(ws + WS_ROUTE) + (size_t)row * 8; const int e0 = ro[0], e1 = ro[1];
            const unsigned long long lt = (1ull << F.lane) - 1ull; int s0 = 0, s1 = 0;
#pragma unroll
            for (int e = 0; e < NEXP; ++e) { const unsigned long long m = __ballot(e0 == e) | __ballot(e1 == e); const int base = pst[e] * 256 + pre[e] + __popcll(m & lt);
                s0 = (e0 == e) ? base : s0; s1 = (e1 == e) ? base : s1; }
            slots[2 * F.lane] = s0; slots[2 * F.lane + 1] = s1;
            T2S[row * 2] = s0; T2S[row * 2 + 1] = s1; SW[s0] = ((const float*)ro)[4]; SW[s1] = ((const float*)ro)[5]; }
        __syncthreads();
#pragma unroll
        for (int i = 0; i < 8; ++i) { const int tl = F.wave * 8 + i; const u32x4 a0 = rv0[i], a1 = rv1[i]; u32x2 f0, f1;
            f0.x = pk4_fp8(bflo(a0.x), bfhi(a0.x), bflo(a0.y), bfhi(a0.y)); f0.y = pk4_fp8(bflo(a0.z), bfhi(a0.z), bflo(a0.w), bfhi(a0.w));
            f1.x = pk4_fp8(bflo(a1.x), bfhi(a1.x), bflo(a1.y), bfhi(a1.y)); f1.y = pk4_fp8(bflo(a1.z), bfhi(a1.z), bflo(a1.w), bfhi(a1.w));
#pragma unroll
            for (int k = 0; k < 2; ++k) { const int slot = slots[2 * tl + k];
                *(u32x2*)(TP + (size_t)slot * 1024 + 8 * F.lane) = f0; *(u32x2*)(TP + (size_t)slot * 1024 + 512 + 8 * F.lane) = f1; } }
        __syncthreads();
    }
}

__device__ __forceinline__ void phase_attention(int l, bool with_ctx, int part) {
    ArgP a = kargs(); Frame F = make_frame(); unsigned char* ws = a->ws;
    const bf16* P = (const bf16*)(ws + WS_PROJ); const bf16* QM = (const bf16*)(ws + WS_D); const bf16* KV = (const bf16*)(ws + WS_C); const bf16* KR = (const bf16*)(ws + WS_KR); bf16* O = (bf16*)(ws + WS_O);
    const int wid = F.wave, bx = blockIdx.x; const float* ctab = (const float*)(ws + WS_ROPE);
    if (part & 1) {
    for (int u = bx; u < 512; u += F.G) { const int bh = (u & 7) + 8 * (u >> 8), qb = (u >> 3) & 31, b = bh >> 3, h = bh & 7; const int qrow0 = b * SEQ + qb * 256 + wid * 32;
        att::attn_unit<96, false, true>(F.lds, QM + (size_t)qrow0 * 768 + h * 96, 768, KV + h * 128, 1024, KV + h * 128 + 64, 1024, KR, O + (size_t)qrow0 * 2048 + 1024 + h * 64, 2048, 128, b * SEQ, TL + b * CTXL, 132, 0, 0, 0, qb * 256 + wid * 32, ctab); }
    if (with_ctx) for (int u = bx; u < 16; u += F.G) { const int b = u >> 3, h = u & 7; const int qrow0 = TL + b * CTXL + wid * 32;
        att::attn_unit<96, false, false>(F.lds, QM + (size_t)qrow0 * 768 + h * 96, 768, KV + h * 128, 1024, KV + h * 128 + 64, 1024, KR, O + (size_t)qrow0 * 2048 + 1024 + h * 64, 2048, 0, 0, TL + b * CTXL, 4, 0, 0, 0, 0, ctab); }
    }
#ifdef ATT_DBG
    if (part & 4) { bf16* OD = (bf16*)(ws + WS_E);
    for (int u = bx; u < 512; u += F.G) { const int bh = (u & 7) + 8 * (u >> 8), qb = (u >> 3) & 31, b = bh >> 3, h = bh & 7; const int qrow0 = b * SEQ + qb * 256 + wid * 32;
        att::attn_unit<96, false, true, ATT_DBG>(F.lds, QM + (size_t)qrow0 * 768 + h * 96, 768, KV + h * 128, 1024, KV + h * 128 + 64, 1024, KR, OD + (size_t)qrow0 * 2048 + 1024 + h * 64, 2048, 128, b * SEQ, TL + b * CTXL, 132, 0, 0, 0, qb * 256 + wid * 32, ctab); }
    }
#endif
    if (!(part & 2)) return;
    const float* rpb = a->na_rpb + (size_t)l * 8 * 465;
    for (int u = bx; u < 512; u += F.G) { const int bh = (u & 7) + 8 * (u >> 8), rb = (u >> 3) & 31, b = bh >> 3, h = bh & 7; const int r0 = 4 * rb;
        {
            LAS float* rp = (LAS float*)(F.lds + att::RPB_OFF); const float* src = rpb + h * 465;
            for (int i = F.tid; i < 465; i += 512) rp[i] = src[i] * LOG2E;
        }
        att::na_unit(F.lds, P, O, b, h, r0); }
    if (with_ctx) for (int u = (F.G >= 32 ? bx - 16 : bx); u < 16; u += F.G) { if (u < 0) break; const int b = u >> 3, h = u & 7; const int qrow0 = TL + b * CTXL + wid * 32;
        att::attn_unit<64, true, false>(F.lds, P + (size_t)qrow0 * NPROJ + C_QA + h * 64, NPROJ, P + C_KA + h * 64, NPROJ, P + C_VA + h * 64, NPROJ, nullptr, O + (size_t)qrow0 * 2048 + h * 64, 2048, 0, 0, TL + b * CTXL, 4, 0, 0, 0, 0, ctab); }
}

template <int KC, int K, int LDB = K>
__device__ __forceinline__ f32x4 sg_block(const Frame& F, const bf16* __restrict__ A, int lda, const bf16* __restrict__ Bt, int rblk, int nblk) {
    constexpr int ROWB = (KC + 8) * 2, ABYTES = 32 * ROWB, STAGE = 96 * ROWB, PPR = KC / 8, RPP = 512 / PPR, NA_ = 32 / RPP, NB_ = 64 / RPP, NS = KC / 32, NCH = K / KC, PD = 3;
    const int tid = F.tid, lane = F.lane, wy = F.wave >> 2, wx = F.wave & 3;
    const int prow = tid / PPR, pc = tid % PPR;
    const bf16* ag = A + (size_t)(rblk + prow) * lda + 8 * pc;
    const bf16* bg = Bt + (size_t)(nblk + prow) * LDB + 8 * pc;
    LAS unsigned char* lds = F.lds;
    const unsigned la = prow * ROWB + pc * 16;
    const LAS unsigned char* ard = lds + (16 * wy + (lane & 15)) * ROWB + (lane >> 4) * 16;
    const LAS unsigned char* brd = lds + ABYTES + (16 * wx + (lane & 15)) * ROWB + (lane >> 4) * 16;
    f32x4 acc = {0.f, 0.f, 0.f, 0.f};
    u32x4 ra[PD + 1][NA_], rb[PD + 1][NB_];
#define SG_LOAD(c_) do { _Pragma("unroll") for (int i = 0; i < NA_; ++i) ra[(c_) % (PD + 1)][i] = *(const u32x4*)(ag + (size_t)(RPP * i) * lda + (c_) * KC); \
        _Pragma("unroll") for (int i = 0; i < NB_; ++i) rb[(c_) % (PD + 1)][i] = *(const u32x4*)(bg + (size_t)(RPP * i) * LDB + (c_) * KC); } while (0)
#define SG_STORE(c_) do { LAS unsigned char* b_ = lds + ((c_) & 1) * STAGE; _Pragma("unroll") for (int i = 0; i < NA_; ++i) *(LAS u32x4*)(b_ + la + i * RPP * ROWB) = ra[(c_) % (PD + 1)][i]; \
        _Pragma("unroll") for (int i = 0; i < NB_; ++i) *(LAS u32x4*)(b_ + ABYTES + la + i * RPP * ROWB) = rb[(c_) % (PD + 1)][i]; } while (0)
#pragma unroll
    for (int c = 0; c < PD && c < NCH; ++c) SG_LOAD(c);
    SG_STORE(0); __syncthreads();
#pragma unroll
    for (int c = 0; c < NCH; ++c) { const int st = c & 1;
        if (c + PD < NCH) SG_LOAD(c + PD);
        bf16x8 av[NS], bv[NS];
#pragma unroll
        for (int ks = 0; ks < NS; ++ks) { av[ks] = *(const LAS bf16x8*)(ard + st * STAGE + ks * 64); bv[ks] = *(const LAS bf16x8*)(brd + st * STAGE + ks * 64); }
#pragma unroll
        for (int ks = 0; ks < NS; ++ks) acc = __builtin_amdgcn_mfma_f32_16x16x32_bf16(av[ks], bv[ks], acc, 0, 0, 0);
        if (c + 1 < NCH) SG_STORE(c + 1);
        __syncthreads();
    }
#undef SG_LOAD
#undef SG_STORE
    return acc;
}
#define SG_BLOCKS(ncb) for (int blk_ = blockIdx.x; blk_ < 16 * (ncb); blk_ += gridDim.x)
#define SG_COORDS(ncb) const int rb_ = blk_ / (ncb), cb_ = blk_ % (ncb); const int rblk = TL + 32 * rb_, nblk = 64 * cb_; const int rowq = rblk + 16 * (F.wave >> 2) + 4 * (F.lane >> 4), col = nblk + 16 * (F.wave & 3) + (F.lane & 15); (void)rowq; (void)col;
__device__ __forceinline__ void sg_store4(bf16* O, int ldo, int rowq, int col, const f32x4& v) {
#pragma unroll
    for (int i = 0; i < 4; ++i) O[(size_t)(rowq + i) * ldo + col] = (bf16)f2bf(v[i]);
}
__device__ __forceinline__ void ctx_kvup(int l) { ArgP a = kargs(); Frame F = make_frame(); unsigned char* ws = a->ws; const bf16* P = (const bf16*)(ws + WS_PROJ); const float* RS = (const float*)(ws + WS_RS);
    const bf16* W = (const bf16*)(ws + WS_WOTHER + (size_t)l * WL_SIZE + WL_WUKV);
    SG_BLOCKS(16) { SG_COORDS(16) f32x4 acc = sg_block<256, 256>(F, P + C_CKV, NPROJ, W, rblk, nblk);
#pragma unroll
        for (int i = 0; i < 4; ++i) acc[i] *= RS[(size_t)(rowq + i) * 2 + 1];
        sg_store4((bf16*)(ws + WS_C), 1024, rowq, col, acc); } }
__device__ __forceinline__ void ctx_qup(int l) { ArgP a = kargs(); Frame F = make_frame(); unsigned char* ws = a->ws; const bf16* P = (const bf16*)(ws + WS_PROJ); const float* RS = (const float*)(ws + WS_RS);
    const bf16* W = (const bf16*)(ws + WS_WOTHER + (size_t)l * WL_SIZE + WL_WUQ);
    SG_BLOCKS(12) { SG_COORDS(12) f32x4 acc = sg_block<128, 384>(F, P + C_CQ, NPROJ, W, rblk, nblk);
#pragma unroll
        for (int i = 0; i < 4; ++i) acc[i] *= RS[(size_t)(rowq + i) * 2] * QS_MLA;
        sg_store4((bf16*)(ws + WS_D), 768, rowq, col, acc); } }
__device__ __forceinline__ void ctx_merge(int l) { ArgP a = kargs(); Frame F = make_frame(); unsigned char* ws = a->ws; const bf16* OB = (const bf16*)(ws + WS_O); const unsigned char* GT = ws + WS_GT;
    const bf16* W = (const bf16*)(ws + WS_WOTHER + (size_t)l * WL_SIZE + WL_WBR);
    SG_BLOCKS(16) { SG_COORDS(16) f32x4 tot = {0.f, 0.f, 0.f, 0.f};
#pragma unroll
        for (int k = 0; k < 4; ++k) { const f32x4 acc = sg_block<256, 512, 2048>(F, OB + k * 512, 2048, W + k * 512, rblk, nblk);
#pragma unroll
            for (int i = 0; i < 4; ++i) tot[i] += acc[i] * (g8((unsigned)GT[gt_byte(rowq + i, k, col)]) * (1.f / 255.f)); }
        sg_store4((bf16*)(ws + WS_C), 1024, rowq, col, tot); } }
__device__ __forceinline__ void ctx_wout(int l) { ArgP a = kargs(); Frame F = make_frame(); unsigned char* ws = a->ws;
    const bf16* W = (const bf16*)(ws + WS_WOTHER + (size_t)l * WL_SIZE + WL_WOUT);
    SG_BLOCKS(16) { SG_COORDS(16) const f32x4 acc = sg_block<256, 1024>(F, (const bf16*)(ws + WS_C), 1024, W, rblk, nblk); sg_store4((bf16*)(ws + WS_D), 1024, rowq, col, acc); } }
__device__ __forceinline__ void ctx_ffn_down() { ArgP a = kargs(); Frame F = make_frame(); unsigned char* ws = a->ws;
    const bf16* W = (const bf16*)(ws + WS_WOTHER + WO_F2);
    SG_BLOCKS(16) { SG_COORDS(16) const f32x4 acc = sg_block<256, DFF>(F, (const bf16*)(ws + WS_PROJ), DFF, W, rblk, nblk); sg_store4((bf16*)(ws + WS_D), 1024, rowq, col, acc); } }

#define PH_BEGIN ArgP a = kargs(); unsigned char* ws = a->ws; LAS unsigned char* lds = make_frame().lds; const int G = gridDim.x, bx = blockIdx.x; (void)lds; (void)G; (void)bx; \
    unsigned char* wl = ws + WS_WOTHER + (size_t)l * WL_SIZE; (void)wl; bf16* PROJ = (bf16*)(ws + WS_PROJ); bf16* OB = (bf16*)(ws + WS_O); bf16* CB = (bf16*)(ws + WS_C); bf16* DB = (bf16*)(ws + WS_D); bf16* EB = (bf16*)(ws + WS_E); \
    float* RS = (float*)(ws + WS_RS); (void)PROJ; (void)OB; (void)CB; (void)DB; (void)EB; (void)RS;
__device__ __forceinline__ void ph_gemm1(int l, int flags) { PH_BEGIN (void)flags;
    { SchedCols S; S.init(T, 8, G, bx, CB, 1024, wl + WL_WIN, 1024, 6, 8, 0); EpiProj E{PROJ, NPROJ, QS_NA, 2, 1.f, ws + WS_GT};
      pg8::gemm_phase(lds, pg8::Gemm{1024, 1024, 1024}, S, E); }
    { const int c2 = G == 256 ? (bx + 128) & 255 : bx;
      SchedCols S; S.init(T, 25, G, c2, ws + WS_H8, 512, wl + WL_WIN, 512, 0, 6, 8); S.tB = (size_t)256 * 2048; EpiProj E{PROJ, NPROJ, QS_NA, 2, 1.f / W13_SCALE, ws + WS_GT};
      pg8::gemm_phase<true>(lds, pg8::Gemm{512, 512, 512}, S, E); } }
__device__ __forceinline__ void ph_kvup(int l) { PH_BEGIN
    SchedStd S; S.init(TL, 1024, G, bx, PROJ + C_CKV, NPROJ, wl + WL_WUKV, 256); EpiRowScale E{CB, 1024, RS + 1, 2, 1.f};
    pg8::gemm_phase(lds, pg8::Gemm{256, NPROJ, 256}, S, E); }
__device__ __forceinline__ void ph_qup(int l, int Mx) { PH_BEGIN
    SchedStd S; S.init(Mx, 768, G, bx, PROJ + C_CQ, NPROJ, wl + WL_WUQ, 384); EpiRowScale E{DB, 768, RS, 2, QS_MLA};
    pg8::gemm_phase(lds, pg8::Gemm{384, NPROJ, 384}, S, E); }
__device__ __forceinline__ void ph_merge(int l, int Mx) { PH_BEGIN
    SchedStd S; S.init(Mx, 1024, G, bx, OB, 2048, wl + WL_WBR, 2048); EpiMergeCat E{CB, ws + WS_GT};
    pg8::gemm_phase(lds, pg8::Gemm{2048, 2048, 2048}, S, E); }
__device__ __forceinline__ void ph_wout(int l, int Mx) { PH_BEGIN
    SchedStd S; S.init(Mx, 1024, G, bx, CB, 1024, wl + WL_WOUT, 1024); EpiRowScale E{DB, 1024, nullptr, 0, 1.f};
    pg8::gemm_phase(lds, pg8::Gemm{1024, 1024, 1024}, S, E); }
__device__ __forceinline__ void ph_ffn_up() { const int l = 0; PH_BEGIN
    SchedStd S; S.init(T, 2 * DFF, G, bx, CB, 1024, ws + WS_WOTHER + WO_F13, 1024); EpiSwiglu E{PROJ, DFF};
    pg8::gemm_phase(lds, pg8::Gemm{1024, 1024, 1024}, S, E); }
__device__ __forceinline__ void ph_ffn_down() { const int l = 0; PH_BEGIN
    SchedStd S; S.init(TL, 1024, G, bx, PROJ, DFF, ws + WS_WOTHER + WO_F2, DFF); EpiRowScale E{DB, 1024, nullptr, 0, 1.f};
    pg8::gemm_phase(lds, pg8::Gemm{DFF, DFF, DFF}, S, E); }
__device__ __forceinline__ void ph_moe_up() { const int l = 1; PH_BEGIN
    int pst[NEXP], npan; moe_panel_starts(ws, pst, npan);
    SchedMoe S; S.init(npan, 2 * DFE, G, bx, EB, 512, ws + WS_WMOE13, 512, pst); EpiSwigluF8 E{ws + WS_HIDM, DFE, 1.f / W13_SCALE};
    pg8::gemm_phase<true>(lds, pg8::Gemm{512, 512, 512}, S, E); }
__device__ __forceinline__ void ph_moe_down() { const int l = 1; PH_BEGIN
    int pst[NEXP], npan; moe_panel_starts(ws, pst, npan); const int nA = npan < 128 ? npan : 128;
    { SchedMoe S; S.init(nA, 1024, G, bx, ws + WS_HIDM, DFE / 2, ws + WS_WMOE2, DFE / 2, pst); EpiRowScale E{EB, 1024, (const float*)(ws + WS_SLOTW), 1, 1.f / W2_SCALE};
      pg8::gemm_phase<true>(lds, pg8::Gemm{DFE / 2, DFE / 2, DFE / 2}, S, E); }
    if (npan > nA) { SchedMoeSplit S; S.init(nA, npan - nA, G, bx, ws + WS_HIDM, ws + WS_WMOE2, pst); EpiSplitF32 E{(float*)(ws + WS_D), (const float*)(ws + WS_SLOTW), nA * 256, 1.f / W2_SCALE};
      pg8::gemm_phase<true>(lds, pg8::Gemm{DFE / 4, DFE / 2, DFE / 2}, S, E); } }

__global__ void __launch_bounds__(512, 2) dit_fwd(Args args_unused) {
    extern __shared__ __attribute__((aligned(16))) unsigned char lds_raw[];
    (void)args_unused;
    LAS unsigned char* lds0 = (LAS unsigned char*)lds_raw;
    volatile LAS unsigned* MISC = (volatile LAS unsigned*)(lds0 + MISC_OFF);
    for (int u = threadIdx.x; u < (LDS_BYTES - LDSCTL_OFF) / 4; u += 512) ((LAS unsigned*)(lds0 + LDSCTL_OFF))[u] = 0u;
    __syncthreads();
    XcdBarrier bar = xcd_barrier_post((unsigned*)(kargs()->ws + WS_CTL) + CW_BAR, MISC + 8);
#define GRID_BAR() xcd_barrier(bar)

#define REP(bit, stmt) do { const int n_ = 1 + ((kargs()->rep >> (bit)) & 1); for (int r_ = 0; r_ < n_; ++r_) { stmt; GRID_BAR(); } } while (0)
    REP(0, phase_prologue());
    REP(1, phase_norm_in());
    for (int l = 0; l < 2; ++l) {
        const int Mx = (l == 0) ? T : TL;
        REP(2, ph_gemm1(l, 0));
        REP(3, phase_prep(l));
        REP(4, (ph_kvup(l), ph_qup(l, TL), ctx_kvup(l), (l == 0 ? ctx_qup(l) : (void)0)));
        { const int n5 = 1 + ((kargs()->rep >> 5) & 1), n11 = 1 + ((kargs()->rep >> 11) & 1);
          for (int r_ = 0; r_ < n5; ++r_) phase_attention(l, l == 0, 1);
#ifdef ATT_DBG
          phase_attention(l, l == 0, 4);
#endif
          for (int r_ = 0; r_ < n11; ++r_) phase_attention(l, l == 0, 2);
          GRID_BAR(); }
        REP(6, (ph_merge(l, TL), (l == 0 ? ctx_merge(l) : (void)0)));
        REP(7, (ph_wout(l, TL), (l == 0 ? ctx_wout(l) : (void)0)));
        if (l == 0) {
            REP(8, (phase_resid<false, false, true, true>(T, WS_D, 0, 2, 1, 2, 0, 3, WS_C)));
            REP(9, ph_ffn_up());
            REP(10, (ph_ffn_down(), ctx_ffn_down()));
            phase_resid<false, false, false, true, true>(T, WS_D, 0, 5, 3, 4, 1, 0, WS_C);
            GRID_BAR();
        } else {
            phase_resid<false, true, false, true>(TL, WS_D, 1, 2, 5, 6, 1, 3, WS_C);
            __syncthreads();
            REP(12, moe_convert());
            REP(13, phase_moe_gather());
            REP(14, ph_moe_up());
            REP(15, ph_moe_down());
            phase_resid<true, false, false, false>(TL, WS_E, 1, 5, 7, 0, 0, 0, WS_C);
        }
    }
}

#ifndef REP_MASK
#define REP_MASK 0
#endif
extern "C" void kernel_launch(void* const* d_in, const int* in_sizes, int n_in, void* d_out, int out_size, void* d_ws, size_t ws_size, hipStream_t stream) {
    static int grid = 0;
    if (grid == 0) {
        if (n_in != 25 || out_size != TL * DM || ws_size < WS_END) { fprintf(stderr, "kernel_launch: unexpected problem (n_in %d, out %d, ws %zu)\n", n_in, out_size, ws_size); grid = -1; return; }
        int dev = 0, cus = 0, per_cu = 0;
        if (hipGetDevice(&dev) != hipSuccess || hipDeviceGetAttribute(&cus, hipDeviceAttributeMultiprocessorCount, dev) != hipSuccess) { grid = -1; return; }
        if (hipFuncSetAttribute((const void*)dit_fwd, hipFuncAttributeMaxDynamicSharedMemorySize, LDS_BYTES) != hipSuccess) { grid = -1; return; }
        if (hipOccupancyMaxActiveBlocksPerMultiprocessor(&per_cu, (const void*)dit_fwd, 512, LDS_BYTES) != hipSuccess || per_cu < 1) { fprintf(stderr, "kernel_launch: occupancy query says %d\n", per_cu); }
        (void)hipGetLastError();
        grid = cus;
    }
    if (grid < 0) return;
    if (hipMemsetAsync((char*)d_ws + WS_CTL, 0, CTL_ZERO_BYTES, stream) != hipSuccess) return;
    Args a{};
    const float** ap = (const float**)&a;
    for (int i = 0; i < 25; ++i) ap[i] = (const float*)d_in[i];
    a.out = (float*)d_out; a.ws = (unsigned char*)d_ws; a.rep = REP_MASK; a.pad = 0;
    hipLaunchKernelGGL(dit_fwd, dim3(grid), dim3(512), LDS_BYTES, stream, a);
}
```
